# Optimizing an MI355X kernel written in HIP

```python
import jax, jax.numpy as jnp
from jax import lax
import numpy as np

D_MODEL = 1024
BATCH = 4
SEQ = 8192
DEPTH = 2

HEAD_DIM = 64
Q_BLOCK = 128
RMS_EPS = 1e-6
ROPE_THETA = 10000.0
FOX_HEADS = 8
MLA_HEADS = 8
MLA_Q_RANK = 384
MLA_KV_RANK = 256
MLA_NOPE_DIM = 64
MLA_ROPE_DIM = 32
MLA_V_DIM = 64
SWA_HEADS = 8
SWA_KV_HEADS = 2
WINDOW = 128
CONV_CHANNELS = 512
CONV_WIDTH = 3
D_FF = 3584
N_EXPERTS = 8
TOP_K = 2

SPLIT_EVEN = (FOX_HEADS * HEAD_DIM, FOX_HEADS * HEAD_DIM, FOX_HEADS * HEAD_DIM, FOX_HEADS,
              MLA_Q_RANK, MLA_KV_RANK, MLA_ROPE_DIM)
SPLIT_ODD = (SWA_HEADS * HEAD_DIM, SWA_KV_HEADS * HEAD_DIM, SWA_KV_HEADS * HEAD_DIM,
             CONV_CHANNELS, CONV_CHANNELS, CONV_CHANNELS)
IN_EVEN = 3 * FOX_HEADS * HEAD_DIM + FOX_HEADS + MLA_Q_RANK + MLA_KV_RANK + MLA_ROPE_DIM
IN_ODD = SWA_HEADS * HEAD_DIM + 2 * SWA_KV_HEADS * HEAD_DIM + 3 * CONV_CHANNELS
MIX_EVEN = FOX_HEADS * HEAD_DIM + MLA_HEADS * MLA_V_DIM
MIX_ODD = SWA_HEADS * HEAD_DIM + CONV_CHANNELS

kernel_name = 'hybrid_fox_mla_swa_conv_moe'


def rms_norm(x, g):
    xf = x.astype(jnp.float32)
    y = xf * lax.rsqrt(jnp.mean(xf * xf, axis=-1, keepdims=True) + RMS_EPS)
    return (y * g.astype(jnp.float32)).astype(x.dtype)


def split_cols(x, sizes):
    out, start = [], 0
    for size in sizes:
        out.append(x[..., start:start + size])
        start += size
    return out


def rope_tables(positions, dim):
    inv_freq = ROPE_THETA ** (-jnp.arange(0, dim, 2, dtype=jnp.float32) / dim)
    ang = positions.astype(jnp.float32)[..., None] * inv_freq
    return jnp.cos(ang), jnp.sin(ang)


def apply_rope(x, cos, sin):
    x1, x2 = jnp.split(x, 2, axis=-1)
    c = cos[:, :, None, :].astype(x.dtype)
    s = sin[:, :, None, :].astype(x.dtype)
    return jnp.concatenate([x1 * c - x2 * s, x2 * c + x1 * s], axis=-1)


def causal_block_attention(q, k, v, scale, decay_cum=None):
    B, S, H, Dk = q.shape
    nb = S // Q_BLOCK
    key_pos = jnp.arange(S)
    q_blocks = jnp.moveaxis(q.reshape(B, nb, Q_BLOCK, H, Dk), 1, 0)
    if decay_cum is not None:
        c_keys = jnp.swapaxes(decay_cum, 1, 2)
        c_blocks = jnp.moveaxis(decay_cum.reshape(B, nb, Q_BLOCK, H), 1, 0)
        xs = (jnp.arange(nb), q_blocks, c_blocks)
    else:
        xs = (jnp.arange(nb), q_blocks)

    def attend(blk):
        n, q_blk = blk[0], blk[1]
        s = jnp.einsum('bqhd,bkhd->bhqk', q_blk, k, preferred_element_type=jnp.float32) * scale
        if decay_cum is not None:
            s = s + jnp.swapaxes(blk[2], 1, 2)[..., :, None] - c_keys[:, :, None, :]
        q_pos = n * Q_BLOCK + jnp.arange(Q_BLOCK)
        s = jnp.where(key_pos[None, :] <= q_pos[:, None], s, -jnp.inf)
        p = jax.nn.softmax(s, axis=-1)
        return jnp.einsum('bhqk,bkhd->bqhd', p.astype(v.dtype), v)

    out = lax.map(attend, xs)
    return jnp.moveaxis(out, 0, 1).reshape(B, S, H, v.shape[-1])


def sliding_window_sink_attention(q, k, v, sinks, scale):
    B, S, Hq, D = q.shape
    Hkv = k.shape[2]
    G = Hq // Hkv
    nb = S // Q_BLOCK
    qb = q.reshape(B, nb, Q_BLOCK, Hkv, G, D)
    kb = k.reshape(B, nb, Q_BLOCK, Hkv, D)
    vb = v.reshape(B, nb, Q_BLOCK, Hkv, D)
    pad = ((0, 0), (1, 0), (0, 0), (0, 0), (0, 0))
    k_band = jnp.concatenate([jnp.pad(kb, pad)[:, :-1], kb], axis=2)
    v_band = jnp.concatenate([jnp.pad(vb, pad)[:, :-1], vb], axis=2)
    s = jnp.einsum('bnqhgd,bnkhd->bnhgqk', qb, k_band, preferred_element_type=jnp.float32) * scale
    kidx = jnp.arange(2 * Q_BLOCK)
    rel = (Q_BLOCK + jnp.arange(Q_BLOCK))[:, None] - kidx[None, :]
    in_window = (rel >= 0) & (rel < WINDOW)
    real_key = (jnp.arange(nb)[:, None] > 0) | (kidx[None, :] >= Q_BLOCK)
    mask = in_window[None, :, :] & real_key[:, None, :]
    s = jnp.where(mask[None, :, None, None], s, -jnp.inf)
    sink = sinks.astype(jnp.float32).reshape(Hkv, G)[None, None, :, :, None, None]
    m = jnp.maximum(jnp.max(s, axis=-1, keepdims=True), sink)
    e = jnp.exp(s - m)
    p = e / (jnp.sum(e, axis=-1, keepdims=True) + jnp.exp(sink - m))
    out = jnp.einsum('bnhgqk,bnkhd->bnqhgd', p.astype(v.dtype), v_band)
    return out.reshape(B, S, Hq * D)


def causal_depthwise_conv(u, w):
    C = u.shape[-1]
    return lax.conv_general_dilated(
        u, w[:, None, :].astype(u.dtype), window_strides=(1,),
        padding=[(CONV_WIDTH - 1, 0)], dimension_numbers=('NWC', 'WIO', 'NWC'),
        feature_group_count=C)


def swiglu(x, w_gate, w_up, w_down):
    return (jax.nn.silu(x @ w_gate) * (x @ w_up)) @ w_down


def moe_swiglu(x, w_router, w_gate, w_up, w_down):
    B, S, D = x.shape
    xt = x.reshape(B * S, D)
    logits = (xt @ w_router).astype(jnp.float32)
    top_vals, top_idx = lax.top_k(logits, TOP_K)
    top_w = jax.nn.softmax(top_vals, axis=-1)
    gates = jnp.einsum('nk,nke->ne', top_w, jax.nn.one_hot(top_idx, N_EXPERTS, dtype=jnp.float32))
    gates = gates.astype(x.dtype)
    y = jnp.zeros_like(xt)
    for e in range(N_EXPERTS):
        y = y + gates[:, e:e + 1] * swiglu(xt, w_gate[e], w_up[e], w_down[e])
    return y.reshape(B, S, D)


def even_layer(h, cos_m, sin_m, norm_mix, w_in, b_forget, q_norm, w_q_up, kv_norm, w_kv_up,
               w_out, norm_ffn, w_gate, w_up, w_down):
    B, S, _ = h.shape
    xn = rms_norm(h, norm_mix)
    fq, fk, fv, f_logit, c_q, c_kv, k_rope = split_cols(xn @ w_in, SPLIT_EVEN)
    log_f = jax.nn.log_sigmoid(f_logit.astype(jnp.float32) + b_forget.astype(jnp.float32))
    decay_cum = jnp.cumsum(log_f, axis=1)
    o_fox = causal_block_attention(
        fq.reshape(B, S, FOX_HEADS, HEAD_DIM), fk.reshape(B, S, FOX_HEADS, HEAD_DIM),
        fv.reshape(B, S, FOX_HEADS, HEAD_DIM), HEAD_DIM ** -0.5, decay_cum)
    q = (rms_norm(c_q, q_norm) @ w_q_up).reshape(B, S, MLA_HEADS, MLA_NOPE_DIM + MLA_ROPE_DIM)
    q_pe = apply_rope(q[..., MLA_NOPE_DIM:], cos_m, sin_m)
    kv = (rms_norm(c_kv, kv_norm) @ w_kv_up).reshape(B, S, MLA_HEADS, MLA_NOPE_DIM + MLA_V_DIM)
    k_nope, v = kv[..., :MLA_NOPE_DIM], kv[..., MLA_NOPE_DIM:]
    k_pe = apply_rope(k_rope.reshape(B, S, 1, MLA_ROPE_DIM), cos_m, sin_m)
    q_full = jnp.concatenate([q[..., :MLA_NOPE_DIM], q_pe], axis=-1)
    k_full = jnp.concatenate(
        [k_nope, jnp.broadcast_to(k_pe, (B, S, MLA_HEADS, MLA_ROPE_DIM))], axis=-1)
    o_mla = causal_block_attention(q_full, k_full, v, (MLA_NOPE_DIM + MLA_ROPE_DIM) ** -0.5)
    mix = jnp.concatenate([o_fox.reshape(B, S, -1), o_mla.reshape(B, S, -1)], axis=-1)
    h = h + mix @ w_out
    return h + swiglu(rms_norm(h, norm_ffn), w_gate, w_up, w_down)


def odd_layer(h, cos_s, sin_s, norm_mix, w_in, sinks, conv_w, w_out, norm_ffn, w_router,
              w_gate, w_up, w_down):
    B, S, _ = h.shape
    xn = rms_norm(h, norm_mix)
    sq, sk, sv, gate_b, gate_c, xc = split_cols(xn @ w_in, SPLIT_ODD)
    q = apply_rope(sq.reshape(B, S, SWA_HEADS, HEAD_DIM), cos_s, sin_s)
    k = apply_rope(sk.reshape(B, S, SWA_KV_HEADS, HEAD_DIM), cos_s, sin_s)
    v = sv.reshape(B, S, SWA_KV_HEADS, HEAD_DIM)
    o_swa = sliding_window_sink_attention(q, k, v, sinks, HEAD_DIM ** -0.5)
    o_conv = gate_b * causal_depthwise_conv(gate_c * xc, conv_w)
    mix = jnp.concatenate([o_swa, o_conv], axis=-1)
    h = h + mix @ w_out
    return h + moe_swiglu(rms_norm(h, norm_ffn), w_router, w_gate, w_up, w_down)


def setup_inputs(seed: int = 0) -> dict:
    key = jax.random.key(seed)
    ks = jax.random.split(key, 26)

    def w(k, shape, fan_in):
        return jax.random.normal(k, shape, jnp.float32) * fan_in ** -0.5

    def gain(k, n):
        return 1.0 + 0.02 * jax.random.normal(k, (n,), jnp.float32)

    x = jax.random.normal(ks[0], (BATCH, SEQ, D_MODEL), jnp.float32)
    offsets = jax.random.randint(ks[1], (BATCH, 1), 0, 4096, dtype=jnp.int32)
    positions = (jnp.arange(SEQ, dtype=jnp.int32)[None, :] + offsets).astype(jnp.int32)
    return {
        'x': x,
        'positions': positions,
        'l0_norm_mix': gain(ks[2], D_MODEL),
        'l0_w_in': w(ks[3], (D_MODEL, IN_EVEN), D_MODEL),
        'l0_b_forget': 2.0 + 0.1 * jax.random.normal(ks[4], (FOX_HEADS,), jnp.float32),
        'l0_q_norm': gain(ks[5], MLA_Q_RANK),
        'l0_w_q_up': w(ks[6], (MLA_Q_RANK, MLA_HEADS * (MLA_NOPE_DIM + MLA_ROPE_DIM)), MLA_Q_RANK),
        'l0_kv_norm': gain(ks[7], MLA_KV_RANK),
        'l0_w_kv_up': w(ks[8], (MLA_KV_RANK, MLA_HEADS * (MLA_NOPE_DIM + MLA_V_DIM)), MLA_KV_RANK),
        'l0_w_out': w(ks[9], (MIX_EVEN, D_MODEL), MIX_EVEN),
        'l0_norm_ffn': gain(ks[10], D_MODEL),
        'l0_w_gate': w(ks[11], (D_MODEL, D_FF), D_MODEL),
        'l0_w_up': w(ks[12], (D_MODEL, D_FF), D_MODEL),
        'l0_w_down': w(ks[13], (D_FF, D_MODEL), D_FF),
        'l1_norm_mix': gain(ks[14], D_MODEL),
        'l1_w_in': w(ks[15], (D_MODEL, IN_ODD), D_MODEL),
        'l1_sinks': 0.5 * jax.random.normal(ks[16], (SWA_HEADS,), jnp.float32),
        'l1_conv_w': w(ks[17], (CONV_WIDTH, CONV_CHANNELS), CONV_WIDTH),
        'l1_w_out': w(ks[18], (MIX_ODD, D_MODEL), MIX_ODD),
        'l1_norm_ffn': gain(ks[19], D_MODEL),
        'l1_w_router': w(ks[20], (D_MODEL, N_EXPERTS), D_MODEL),
        'l1_w_gate': w(ks[21], (N_EXPERTS, D_MODEL, D_FF), D_MODEL),
        'l1_w_up': w(ks[22], (N_EXPERTS, D_MODEL, D_FF), D_MODEL),
        'l1_w_down': w(ks[23], (N_EXPERTS, D_FF, D_MODEL), D_FF),
        'final_norm': gain(ks[24], D_MODEL),
    }


def reference(x, positions, l0_norm_mix, l0_w_in, l0_b_forget, l0_q_norm, l0_w_q_up, l0_kv_norm,
              l0_w_kv_up, l0_w_out, l0_norm_ffn, l0_w_gate, l0_w_up, l0_w_down,
              l1_norm_mix, l1_w_in, l1_sinks, l1_conv_w, l1_w_out, l1_norm_ffn, l1_w_router,
              l1_w_gate, l1_w_up, l1_w_down, final_norm):
    cos_m, sin_m = rope_tables(positions, MLA_ROPE_DIM)
    cos_s, sin_s = rope_tables(positions, HEAD_DIM)
    layer_params = (
        (l0_norm_mix, l0_w_in, l0_b_forget, l0_q_norm, l0_w_q_up, l0_kv_norm, l0_w_kv_up,
         l0_w_out, l0_norm_ffn, l0_w_gate, l0_w_up, l0_w_down),
        (l1_norm_mix, l1_w_in, l1_sinks, l1_conv_w, l1_w_out, l1_norm_ffn, l1_w_router,
         l1_w_gate, l1_w_up, l1_w_down),
    )
    h = x
    for i in range(DEPTH):
        if i % 2 == 0:
            h = even_layer(h, cos_m, sin_m, *layer_params[i])
        else:
            h = odd_layer(h, cos_s, sin_s, *layer_params[i])
    return rms_norm(h, final_norm)
```

```cpp
#include <hip/hip_runtime.h>
#include <cstdio>
#include <cstdint>
#include <cmath>
namespace pg8 {
#define PG8_LAS __attribute__((address_space(3)))
typedef unsigned short bf16_t;
typedef short bf16x8 __attribute__((ext_vector_type(8)));
typedef float f32x4 __attribute__((ext_vector_type(4)));
typedef float f32x2 __attribute__((ext_vector_type(2)));
typedef unsigned u32x4 __attribute__((ext_vector_type(4)));
typedef unsigned u32x2 __attribute__((ext_vector_type(2)));
constexpr int BM = 256, BK = 64, HALF = 128, HTB = HALF * BK * 2  , STAGE_BYTES = 8 * HTB, NXCD = 8, WGM = 8;

__host__ __device__ __forceinline__ int lds_byte(int r, int c) { const int st = (r >> 4) * 2 + (c >> 5), rr = r & 15, cc = c & 31, ob = rr * 64 + cc * 2; return st * 1024 + (ob ^ (((ob >> 9) & 1) << 5)); }
__host__ __device__ __forceinline__ void stage_rc(int b, int& R, int& C) { const int st = b / 1024, sb = b % 1024, swz = sb ^ (((sb >> 9) & 1) << 5); R = (st >> 1) * 16 + swz / 64; C = (st & 1) * 32 + (swz % 64) / 2; }
__host__ __device__ __forceinline__ int perm32(int rho) { const int n = rho >> 4, i = rho & 15; return 8 * (i >> 2) + 4 * n + (i & 3); }

struct Unit { int pa, pb, pm, pn, e, nv, s0; };

struct StaticOrder {
    int nM, nN, nwg, G, c;
    __device__ __forceinline__ void init(int nM_, int nN_, int G_, int c_) { nM = nM_; nN = nN_; nwg = nM * nN; G = G_; c = c_; }
    __device__ __forceinline__ bool tile(int i, int& pm, int& pn) const {
        const long L = (long)i * G + c; if (L >= nwg) return false;
        int wgid = (int)L; { const int q = nwg / NXCD, r = nwg % NXCD, xcd = wgid % NXCD, off = wgid / NXCD; wgid = (xcd < r ? xcd * (q + 1) : r * (q + 1) + (xcd - r) * q) + off; }
        const int nig = WGM * nN, gid = wgid / nig, fm = gid * WGM, gsz = (nM - fm) < WGM ? (nM - fm) : WGM;
        pm = fm + ((wgid % nig) % gsz); pn = (wgid % nig) / gsz; return true;
    }
    __device__ __forceinline__ bool next(int i, Unit& u) const { int pm, pn; if (!tile(i, pm, pn)) return false; u.pa = pm; u.pb = pn; u.pm = pm; u.pn = pn; u.e = 0; u.nv = 256; u.s0 = 0; return true; }
    __device__ __forceinline__ void fill(const Unit&, PG8_LAS unsigned*, int, int) const {}
};

__device__ __forceinline__ unsigned cvt_pk_bf16(float lo, float hi) { unsigned r; asm volatile("v_cvt_pk_bf16_f32 %0, %1, %2" : "=v"(r) : "v"(lo), "v"(hi)); return r; }
__device__ __forceinline__ u32x4 pack8(const f32x4 v0, const f32x4 v1) { u32x4 w; w.x = cvt_pk_bf16(v0[0], v0[1]); w.y = cvt_pk_bf16(v0[2], v0[3]); w.z = cvt_pk_bf16(v1[0], v1[1]); w.w = cvt_pk_bf16(v1[2], v1[3]); return w; }

template <class Epi, class Sched, bool GATHER>
__device__ __forceinline__ void gemm_phase(PG8_LAS unsigned char* lds, const bf16_t* Ag, const bf16_t* Btg, const int K, const Sched& S, const Epi& E) {
    const int tid = threadIdx.x, wid = __builtin_amdgcn_readfirstlane(tid >> 6), lane = tid & 63, wr = wid >> 2, wc = wid & 3, fr = lane & 15, fq = lane >> 4;
    const int nt = K / BK;
    unsigned voffA[2], voffB[2];
#pragma unroll
    for (int i = 0; i < 2; ++i) { int R, C; stage_rc(tid * 16 + i * 8192, R, C); const int Rb = (R & ~31) + perm32(R & 31);
        voffA[i] = (unsigned)(R * K + C) * 2u; voffB[i] = (unsigned)(Rb * K + C) * 2u; }
    const size_t kstep = (size_t)(BK * 2);
    const size_t hstep = (size_t)HALF * K * 2;
    const size_t tstep = 2 * hstep;
    const unsigned ldsw = (unsigned)wid * 1024u;
    const int aoff = lds_byte(wr * 64 + fr, fq * 8), boff = lds_byte(wc * 32 + fr, fq * 8);
#define PG8_SA(b, h) (((b) * 2 + (h)) * HTB)
#define PG8_SB(b, h) ((4 + (b) * 2 + (h)) * HTB)
#define PG8_STAGE(bufoff, gbase, voff) do { _Pragma("unroll") for (int _i = 0; _i < 2; ++_i) \
        __builtin_amdgcn_global_load_lds((const unsigned*)((const char*)(gbase) + (voff)[_i]), (PG8_LAS unsigned*)(lds + (bufoff) + ldsw + _i * 8192), 16, 0, 0); } while (0)
#define PG8_STAGE_A(bufoff, aptr, h) do { if constexpr (GATHER) { PG8_STAGE(bufoff, aptr, vgC[h]); } else { PG8_STAGE(bufoff, (aptr) + (h) * hstep, voffA); } } while (0)
#define PG8_LOOKUP(tabp, nvv) do { int t_ = tid; asm volatile("" : "+v"(t_));   \
        _Pragma("unroll") for (int _j = 0; _j < 2; ++_j) { int R_, C_; stage_rc(t_ * 16 + _j * 8192, R_, C_); _Pragma("unroll") for (int _h = 0; _h < 2; ++_h) { const int r_ = _h * 128 + R_; unsigned tk_ = (tabp)[r_]; tk_ = r_ < (nvv) ? tk_ : 0u; \
        vgC[_h][_j] = (tk_ * (unsigned)K + (unsigned)C_) * 2u; } } } while (0)
#define PG8_LDA(dst, b, h) do { _Pragma("unroll") for (int m = 0; m < 4; ++m) _Pragma("unroll") for (int k = 0; k < 2; ++k) dst[m][k] = *(const PG8_LAS bf16x8*)(lds + PG8_SA(b, h) + aoff + m * 2048 + k * 1024); } while (0)
#define PG8_LDB(dst, b, h) do { _Pragma("unroll") for (int n = 0; n < 2; ++n) _Pragma("unroll") for (int k = 0; k < 2; ++k) dst[n][k] = *(const PG8_LAS bf16x8*)(lds + PG8_SB(b, h) + boff + n * 2048 + k * 1024); } while (0)
#define PG8_MMA(ai, bj, At, Bt) do { __builtin_amdgcn_s_setprio(1); _Pragma("unroll") for (int m = 0; m < 4; ++m) _Pragma("unroll") for (int n = 0; n < 2; ++n) _Pragma("unroll") for (int k = 0; k < 2; ++k) \
        acc[ai][bj][m][n] = __builtin_amdgcn_mfma_f32_16x16x32_bf16(Bt[n][k], At[m][k], acc[ai][bj][m][n], 0, 0, 0); __builtin_amdgcn_s_setprio(0); } while (0)
#define PG8_WAIT_V(n) asm volatile("s_waitcnt vmcnt(" #n ")" ::: "memory")
#define PG8_WAIT_L(n) asm volatile("s_waitcnt lgkmcnt(" #n ")" ::: "memory")
#define PG8_BAR __builtin_amdgcn_s_barrier()
#define PG8_SCHED __builtin_amdgcn_sched_barrier(0)
    Unit cur, nxt; int ui = 0;
    if (!S.next(0, cur)) return;
    f32x4 acc[2][2][4][2];
#pragma unroll
    for (int a = 0; a < 2; ++a)
#pragma unroll
        for (int b = 0; b < 2; ++b)
#pragma unroll
            for (int m = 0; m < 4; ++m)
#pragma unroll
                for (int n = 0; n < 2; ++n) acc[a][b][m][n] = (f32x4){0.f, 0.f, 0.f, 0.f};
    bf16x8 At[4][2], B0[2][2], B1[2][2];
    PG8_LAS unsigned* gtab = (PG8_LAS unsigned*)(lds + STAGE_BYTES + 1024);
    const PG8_LAS unsigned* tabC = gtab; const PG8_LAS unsigned* tabN = gtab + 256;
    unsigned vgC[2][2] = {{0u, 0u}, {0u, 0u}};
    if constexpr (GATHER) { S.fill(cur, gtab, wid, lane); PG8_WAIT_V(0); PG8_BAR; PG8_LOOKUP(tabC, cur.nv); }
    const char* cA = GATHER ? (const char*)Ag : (const char*)Ag + (size_t)cur.pa * tstep; const char* cB = (const char*)Btg + (size_t)cur.pb * tstep;
    PG8_STAGE(PG8_SB(0, 0), cB, voffB); PG8_STAGE(PG8_SB(0, 1), cB + hstep, voffB); PG8_STAGE_A(PG8_SA(0, 0), cA, 0); PG8_STAGE_A(PG8_SA(0, 1), cA, 1);
    if (wr == 1) PG8_BAR;
    PG8_WAIT_V(2); PG8_BAR;
    PG8_STAGE(PG8_SB(1, 0), cB + kstep, voffB); PG8_STAGE_A(PG8_SA(1, 0), cA + kstep, 0); PG8_STAGE(PG8_SB(1, 1), cB + hstep + kstep, voffB);
    PG8_WAIT_V(6); PG8_BAR;
    for (;;) {
        const bool has_next = S.next(ui + 1, nxt);
        if constexpr (GATHER) { if (has_next) S.fill(nxt, (PG8_LAS unsigned*)tabN, wid, lane); }
        const char* nA = GATHER ? cA : (has_next ? (const char*)Ag + (size_t)nxt.pa * tstep : cA); const char* nB = has_next ? (const char*)Btg + (size_t)nxt.pb * tstep : cB;
#pragma nounroll
        for (int t = 0; t < nt; t += 2) {
            const bool last = (t == nt - 2);
            const char* a1 = cA + (size_t)(t + 1) * kstep;
            const char* a2 = last ? nA : cA + (size_t)(t + 2) * kstep; const char* b2 = last ? nB : cB + (size_t)(t + 2) * kstep;
            const char* a3 = a2 + kstep; const char* b3 = b2 + kstep;
            PG8_LDB(B0, 0, 0); PG8_LDB(B1, 0, 1); PG8_SCHED; PG8_LDA(At, 0, 0); PG8_STAGE_A(PG8_SA(1, 1), a1, 1);
            if constexpr (GATHER) { if (last && has_next) PG8_LOOKUP(tabN, nxt.nv); }
            PG8_WAIT_V(8); PG8_WAIT_L(0); PG8_BAR; PG8_MMA(0, 0, At, B0); PG8_MMA(0, 1, At, B1); PG8_BAR; PG8_SCHED;
            PG8_LDA(At, 0, 1); PG8_STAGE(PG8_SB(0, 0), b2, voffB); PG8_STAGE(PG8_SB(0, 1), b2 + hstep, voffB); PG8_STAGE_A(PG8_SA(0, 0), a2, 0);
            PG8_WAIT_V(8); PG8_WAIT_L(0); PG8_BAR; PG8_MMA(1, 0, At, B0); PG8_MMA(1, 1, At, B1); PG8_BAR; PG8_SCHED;
            PG8_LDB(B0, 1, 0); PG8_LDB(B1, 1, 1); PG8_SCHED; PG8_LDA(At, 1, 0); PG8_STAGE_A(PG8_SA(0, 1), a2, 1);
            PG8_WAIT_V(8); PG8_WAIT_L(0); PG8_BAR; PG8_MMA(0, 0, At, B0); PG8_MMA(0, 1, At, B1); PG8_BAR; PG8_SCHED;
            PG8_LDA(At, 1, 1); PG8_STAGE(PG8_SB(1, 0), b3, voffB); PG8_STAGE(PG8_SB(1, 1), b3 + hstep, voffB); PG8_STAGE_A(PG8_SA(1, 0), a3, 0);
            PG8_WAIT_V(8); PG8_WAIT_L(0); PG8_BAR; PG8_MMA(1, 0, At, B0); PG8_MMA(1, 1, At, B1); PG8_BAR; PG8_SCHED;
        }
        if (wr == 0) PG8_BAR;
        E(acc, cur, wr, wc, fr, fq);
        if (!has_next) break;
#pragma unroll
        for (int a = 0; a < 2; ++a)
#pragma unroll
            for (int b = 0; b < 2; ++b)
#pragma unroll
                for (int m = 0; m < 4; ++m)
#pragma unroll
                    for (int n = 0; n < 2; ++n) acc[a][b][m][n] = (f32x4){0.f, 0.f, 0.f, 0.f};
        cur = nxt; cA = nA; cB = nB; ++ui;
        if constexpr (GATHER) { const PG8_LAS unsigned* t_ = tabC; tabC = tabN; tabN = t_; }
        if (wr == 1) PG8_BAR;
    }
    PG8_WAIT_V(0);
    PG8_BAR;
#undef PG8_SA
#undef PG8_SB
#undef PG8_STAGE
#undef PG8_STAGE_A
#undef PG8_LOOKUP
#undef PG8_LDA
#undef PG8_LDB
#undef PG8_MMA
#undef PG8_WAIT_V
#undef PG8_WAIT_L
#undef PG8_BAR
#undef PG8_SCHED
}
}
namespace att {
using bf16x8 = __attribute__((ext_vector_type(8))) short;
using s16x4 = __attribute__((ext_vector_type(4))) short;
using f32x16 = __attribute__((ext_vector_type(16))) float;
using u32x4 = __attribute__((ext_vector_type(4))) unsigned;
typedef unsigned short bf16_t;
constexpr int NW = 8, QBLK = 32, QB = 256, KVBLK = 64;
constexpr int KSLOT = 12288, VSLOT = 8192, NSLOT = 2;
constexpr int LDS_K = 0, LDS_V = NSLOT * KSLOT, LDS_WS = LDS_V + NSLOT * VSLOT, LDS_OST = LDS_WS + NW * 256, LDS_BYTES = LDS_OST + NW * 4096;
__device__ __forceinline__ int crow(int r, int hi) { return (r & 3) + 8 * (r >> 2) + 4 * hi; }
__device__ __forceinline__ void glds16(const void* gsrc, unsigned lds_dst) { unsigned keep;
    asm volatile("s_mov_b32 %0, m0\n\ts_mov_b32 m0, %2\n\ts_nop 0\n\tglobal_load_lds_dwordx4 %1, off\n\ts_mov_b32 m0, %0" : "=&s"(keep) : "v"(gsrc), "s"(lds_dst) : "memory"); }
typedef float f32x2_t __attribute__((ext_vector_type(2))); typedef __bf16 bf16x2_t __attribute__((ext_vector_type(2)));
__device__ __forceinline__ unsigned cvtpk_s(float lo, float hi) { f32x2_t v = {lo, hi}; bf16x2_t b = __builtin_convertvector(v, bf16x2_t); return __builtin_bit_cast(unsigned, b); }
__device__ __forceinline__ unsigned short f2bf_s(float f) { return (unsigned short)(cvtpk_s(f, 0.f) & 0xffffu); }
#define ATT_WAIT_BAR() asm volatile("s_waitcnt vmcnt(0) lgkmcnt(0)\n\ts_barrier" ::: "memory")

struct Ptrs {
    const bf16_t* Qm; int qp; const bf16_t* Qx; int qxp; const bf16_t* Km; int kp; const bf16_t* Kx; int kxp; const bf16_t* V; int vp; bf16_t* O; int op;
};

template <int NKC>
__device__ __forceinline__ void qkt(f32x16& p0, f32x16& p1, const char* Kslot, const bf16x8* qr, const f32x16& negm, int r32, int hi) {
    const char* kb = Kslot + hi * 1024 + r32 * 16;
#pragma unroll
    for (int d0 = 0; d0 < NKC; ++d0) {
        const bf16x8 b0 = *reinterpret_cast<const bf16x8*>(kb + d0 * 2048);
        const bf16x8 b1 = *reinterpret_cast<const bf16x8*>(kb + d0 * 2048 + 512);
        if (d0 == 0) { p0 = __builtin_amdgcn_mfma_f32_32x32x16_bf16(b0, qr[0], negm, 0, 0, 0); p1 = __builtin_amdgcn_mfma_f32_32x32x16_bf16(b1, qr[0], negm, 0, 0, 0); }
        else { p0 = __builtin_amdgcn_mfma_f32_32x32x16_bf16(b0, qr[d0], p0, 0, 0, 0); p1 = __builtin_amdgcn_mfma_f32_32x32x16_bf16(b1, qr[d0], p1, 0, 0, 0); }
    }
}
__device__ __forceinline__ float rowmax(const f32x16& p0, const f32x16& p1) {
    float a = fmaxf(p0[0], p1[0]);
#pragma unroll
    for (int r = 1; r < 16; ++r) a = fmaxf(a, fmaxf(p0[r], p1[r]));
    auto rr = __builtin_amdgcn_permlane32_swap(__float_as_uint(a), __float_as_uint(a), false, false);
    return fmaxf(__uint_as_float(rr[0]), __uint_as_float(rr[1]));
}
__device__ __forceinline__ void pv(f32x16* o, int vb, bf16x8 pa0, bf16x8 pa1, bf16x8 pa2, bf16x8 pa3) {
#pragma unroll
    for (int d0 = 0; d0 < 2; ++d0) { s16x4 lo[4], hi[4];
#pragma unroll
        for (int ks = 0; ks < 4; ++ks) {
            asm volatile("ds_read_b64_tr_b16 %0,%1 offset:%c2" : "=&v"(lo[ks]) : "v"(vb), "i"(d0 * 4096 + ks * 1024) : "memory");
            asm volatile("ds_read_b64_tr_b16 %0,%1 offset:%c2" : "=&v"(hi[ks]) : "v"(vb), "i"(d0 * 4096 + ks * 1024 + 512) : "memory"); }
        asm volatile("s_waitcnt lgkmcnt(0)" ::: "memory"); __builtin_amdgcn_sched_barrier(0);
#define ATT_PK(k) (bf16x8){lo[k][0], lo[k][1], lo[k][2], lo[k][3], hi[k][0], hi[k][1], hi[k][2], hi[k][3]}
        o[d0] = __builtin_amdgcn_mfma_f32_32x32x16_bf16(pa0, ATT_PK(0), o[d0], 0, 0, 0);
        o[d0] = __builtin_amdgcn_mfma_f32_32x32x16_bf16(pa1, ATT_PK(1), o[d0], 0, 0, 0);
        o[d0] = __builtin_amdgcn_mfma_f32_32x32x16_bf16(pa2, ATT_PK(2), o[d0], 0, 0, 0);
        o[d0] = __builtin_amdgcn_mfma_f32_32x32x16_bf16(pa3, ATT_PK(3), o[d0], 0, 0, 0);
#undef ATT_PK
    }
}

template <int NKC, int MODE, bool QONES>
__device__ __forceinline__ void attn_unit(const Ptrs& P, int q0, float sink_l2, char* shm) {
    constexpr float THR = 8.f;
    const int tid = threadIdx.x, lane = tid & 63, r32 = lane & 31, hi = lane >> 5; const int wid = __builtin_amdgcn_readfirstlane(tid >> 6);
    const unsigned lds0 = (unsigned)(uintptr_t)shm;
    float* wsf = (float*)(shm + LDS_WS) + wid * 64;
    const int qmin = q0 + wid * QBLK, qmax = qmin + QBLK - 1, qabs = qmin + r32;
    int t0 = 0; if (MODE == 1) { int lo = q0 - 127; if (lo < 0) lo = 0; t0 = lo / KVBLK; }
    const int t1 = (q0 + QB) / KVBLK - 1;
    const bf16_t* ksrc = P.Km + (long)lane * P.kp + wid * 8;
    const bf16_t* kxsrc = (NKC > 4) ? P.Kx + (long)lane * P.kxp + wid * 8 : nullptr;
    const bf16_t* vsrc = P.V + (long)(16 * (wid & 3) + (lane >> 2)) * P.vp + (wid >> 2) * 32 + (lane & 3) * 8;
    const unsigned kdst = lds0 + LDS_K + wid * 1024, kxdst = lds0 + LDS_K + (8 + wid) * 1024, vdst = lds0 + LDS_V + wid * 1024;
#define ATT_DMA(t, s) do { glds16(ksrc + (long)(t) * KVBLK * P.kp, (unsigned)__builtin_amdgcn_readfirstlane(kdst + (s) * KSLOT)); \
        if (NKC > 4 && wid < 2 * (NKC - 4)) glds16(kxsrc + (long)(t) * KVBLK * P.kxp, (unsigned)__builtin_amdgcn_readfirstlane(kxdst + (s) * KSLOT)); \
        glds16(vsrc + (long)(t) * KVBLK * P.vp, (unsigned)__builtin_amdgcn_readfirstlane(vdst + (s) * VSLOT)); } while (0)
    const int vb0 = (int)(lds0 + LDS_V) + ((lane >> 4) & 1) * 32 + (lane & 3) * 8 + (4 * hi + ((lane & 15) >> 2)) * 64;
    ATT_DMA(t0, 0);
    bf16x8 qr[NKC];
#pragma unroll
    for (int d0 = 0; d0 < 4; ++d0) qr[d0] = *reinterpret_cast<const bf16x8*>(P.Qm + (long)qabs * P.qp + d0 * 16 + hi * 8);
    if constexpr (NKC > 4) {
        if constexpr (QONES) { const short one = (short)0x3F80; qr[4] = hi == 0 ? (bf16x8){one, one, one, 0, 0, 0, 0, 0} : (bf16x8){0, 0, 0, 0, 0, 0, 0, 0}; }
        else {
#pragma unroll
            for (int d0 = 4; d0 < NKC; ++d0) qr[d0] = *reinterpret_cast<const bf16x8*>(P.Qx + (long)qabs * P.qxp + (d0 - 4) * 16 + hi * 8);
        }
    }
    float mhat = (MODE == 1) ? sink_l2 : 0.f, l_reg = (MODE == 1 && hi == 0) ? 1.f : 0.f;
    f32x16 o[2]; o[0] = f32x16{}; o[1] = f32x16{};
    f32x16 negm;
#pragma unroll
    for (int r = 0; r < 16; ++r) negm[r] = -mhat;
    bool first = (MODE == 0);
    for (int t = t0; t <= t1; ++t) {
        const int s = (t - t0) & 1;
        ATT_WAIT_BAR();
        if (t < t1) ATT_DMA(t + 1, s ^ 1);
        const int k0 = t * KVBLK;
        const bool active = (k0 <= qmax) && (MODE == 0 || k0 + 63 >= qmin - 127);
        if (active) {
            f32x16 p0, p1;
            qkt<NKC>(p0, p1, shm + LDS_K + s * KSLOT, qr, negm, r32, hi);
            const bool needmask = (k0 + 63 > qmin) || (MODE == 1 && k0 < qmax - 127);
            if (needmask) {
#pragma unroll
                for (int r = 0; r < 16; ++r) { const int kv = k0 + crow(r, hi);
                    bool ok0 = kv <= qabs, ok1 = kv + 32 <= qabs;
                    if (MODE == 1) { ok0 = ok0 && (qabs - kv < 128); ok1 = ok1 && (qabs - kv - 32 < 128); }
                    if (!ok0) p0[r] = -INFINITY; if (!ok1) p1[r] = -INFINITY; }
            }
            const float rm = rowmax(p0, p1);
            if (first) {
                first = false; mhat = rm;
#pragma unroll
                for (int r = 0; r < 16; ++r) { p0[r] -= rm; p1[r] -= rm; negm[r] = -mhat; }
            } else if (__any(rm > THR)) {
                const float dl = fmaxf(rm, 0.f); mhat += dl;
#pragma unroll
                for (int r = 0; r < 16; ++r) { p0[r] -= dl; p1[r] -= dl; negm[r] = -mhat; }
                const float f = __builtin_amdgcn_exp2f(-dl); l_reg *= f; if (hi == 0) wsf[r32] = f;
                asm volatile("s_waitcnt lgkmcnt(0)" ::: "memory");
#pragma unroll
                for (int d_ = 0; d_ < 2; ++d_)
#pragma unroll
                    for (int r = 0; r < 16; ++r) o[d_][r] *= wsf[crow(r, hi)];
            }
            float sacc = 0.f;
#pragma unroll
            for (int r = 0; r < 16; ++r) { p0[r] = __builtin_amdgcn_exp2f(p0[r]); p1[r] = __builtin_amdgcn_exp2f(p1[r]); sacc += p0[r] + p1[r]; }
            l_reg += sacc;
            u32x4 pw0, pw1, pw2, pw3;
            pw0 = (u32x4){cvtpk_s(p0[0], p0[1]), cvtpk_s(p0[2], p0[3]), cvtpk_s(p0[4], p0[5]), cvtpk_s(p0[6], p0[7])};
            pw1 = (u32x4){cvtpk_s(p0[8], p0[9]), cvtpk_s(p0[10], p0[11]), cvtpk_s(p0[12], p0[13]), cvtpk_s(p0[14], p0[15])};
            pw2 = (u32x4){cvtpk_s(p1[0], p1[1]), cvtpk_s(p1[2], p1[3]), cvtpk_s(p1[4], p1[5]), cvtpk_s(p1[6], p1[7])};
            pw3 = (u32x4){cvtpk_s(p1[8], p1[9]), cvtpk_s(p1[10], p1[11]), cvtpk_s(p1[12], p1[13]), cvtpk_s(p1[14], p1[15])};
            pv(o, vb0 + s * VSLOT, __builtin_bit_cast(bf16x8, pw0), __builtin_bit_cast(bf16x8, pw1), __builtin_bit_cast(bf16x8, pw2), __builtin_bit_cast(bf16x8, pw3));
        }
    }
    { auto rr = __builtin_amdgcn_permlane32_swap(__float_as_uint(l_reg), __float_as_uint(l_reg), false, false); l_reg = __uint_as_float(rr[0]) + __uint_as_float(rr[1]); }
    if (hi == 0) wsf[32 + r32] = l_reg;
    asm volatile("s_waitcnt lgkmcnt(0)" ::: "memory");
    float rli[16];
#pragma unroll
    for (int r = 0; r < 16; ++r) rli[r] = __builtin_amdgcn_rcpf(wsf[32 + crow(r, hi)]);
    bf16_t* Ow = P.O + (long)qmin * P.op;
    { bf16_t* stg = (bf16_t*)(shm + LDS_OST) + wid * 2048;
#pragma unroll
        for (int r = 0; r < 16; ++r) { const int orow = crow(r, hi);
#pragma unroll
            for (int d0 = 0; d0 < 2; ++d0) stg[orow * 64 + d0 * 32 + r32] = f2bf_s(o[d0][r] * rli[r]); }
        asm volatile("s_waitcnt lgkmcnt(0)" ::: "memory");
#pragma unroll
        for (int i = 0; i < 4; ++i) { const int row = i * 8 + (lane >> 3), ch = lane & 7; const u32x4 v = *(const u32x4*)(stg + row * 64 + ch * 8); *(u32x4*)(Ow + (long)row * P.op + ch * 8) = v; } }
    asm volatile("s_waitcnt lgkmcnt(0)\n\ts_barrier" ::: "memory");
#undef ATT_DMA
}
#undef ATT_WAIT_BAR
}
constexpr int NWAVES = 8;
constexpr int NTOK = 32768, SEQ = 8192, NB = 4, DM = 1024, DFF = 3584, NEXP = 8;
constexpr float RMS_EPS = 1e-6f;
constexpr float LOG2E = 1.4426950408889634f;
constexpr float C2_FOX = 0.125f * LOG2E, C2_MLA = 0.10206207261596577f * LOG2E, C2_SWA = 0.125f * LOG2E;
constexpr size_t MiB = 1u << 20;
constexpr size_t WS_CTL = 0, CTL_ZERO_BYTES = 64 * 1024;
constexpr size_t WS_WMOE_GU = 2 * MiB;
constexpr size_t WS_WMOE_D = 114 * MiB;
constexpr size_t WS_XB = 170 * MiB;
constexpr size_t WS_BIG = 234 * MiB;
constexpr size_t WS_CQ = WS_BIG, WS_KPE = 258 * MiB, WS_MQ = 260 * MiB, WS_MKV = 308 * MiB, WS_MIX0 = 372 * MiB;
constexpr size_t WS_W_IN0 = 436 * MiB, WS_W_QUP = 441 * MiB, WS_W_KVUP = 442 * MiB, WS_W_OUT0 = 443 * MiB, WS_CSM = 445 * MiB, WS_FL = 449 * MiB;
constexpr size_t WS_HID0 = WS_BIG;
constexpr size_t WS_W_GU0 = 458 * MiB, WS_W_D0 = 472 * MiB, WS_W_IN1 = 479 * MiB, WS_W_OUT1 = 484 * MiB, WS_CSS = 486 * MiB;
constexpr size_t WS_SQ = WS_BIG, WS_SK = 266 * MiB, WS_SV = 274 * MiB, WS_GB = 282 * MiB, WS_U = 314 * MiB, WS_MIX1 = 346 * MiB;
constexpr size_t WS_LIST = WS_BIG, WS_HID1 = 242 * MiB;
constexpr int MOE_CAP = 135;
constexpr size_t WS_END = 499 * MiB;
constexpr size_t DO_FQ = 0, DO_FK = 32 * MiB, DO_FV = 64 * MiB, DO_KB = 96 * MiB, DO_CKV = 104 * MiB;
constexpr int CW_TMO = 0, CW_CODE = 1, CW_BAR = 4096, CW_CNT = 8192;
constexpr size_t WS_PQ = 494 * MiB, WS_PKV = 495 * MiB, WS_PH = 496 * MiB;
constexpr int RING_OFF = 0, RING_BYTES = 131072;
constexpr int LDSCTL_OFF = RING_BYTES, MISC_OFF = LDSCTL_OFF + 320;
constexpr int LDS_BYTES = 147456;

#define GAS __attribute__((address_space(1)))
#define LAS __attribute__((address_space(3)))
typedef unsigned short bf16;
typedef unsigned v4u __attribute__((ext_vector_type(4)));
typedef unsigned v2u __attribute__((ext_vector_type(2)));
typedef float f32x4 __attribute__((ext_vector_type(4)));
typedef float f32x2 __attribute__((ext_vector_type(2)));
typedef GAS unsigned gu32;
#define RLX_AGENT __ATOMIC_RELAXED, __HIP_MEMORY_SCOPE_AGENT
#define LDS_WAIT() asm volatile("s_waitcnt lgkmcnt(0)" ::: "memory")
#define VM_WAIT() asm volatile("s_waitcnt vmcnt(0)" ::: "memory")
__device__ __forceinline__ unsigned f2bf(float f) { unsigned u = __builtin_bit_cast(unsigned, f); return (u + 0x7fffu + ((u >> 16) & 1u)) >> 16; }
__device__ __forceinline__ float bf2f(unsigned b) { return __builtin_bit_cast(float, b << 16); }
__device__ __forceinline__ unsigned pk2(float lo, float hi) { return f2bf(lo) | (f2bf(hi) << 16); }

#define XB_TMO      128
#define XB_XCNT(j)  (256  + 64 * (j))
#define XB_XSUB(j)  (1280 + 64 * (j))
#define XB_XGEN(j)  (2304 + 64 * (j))
#define XB_TOP      3328
#define XB_TOPGEN   3392
#define XCD_BAR_WORDS 3456
#define XB_SPIN_CAP (1u << 18)
__device__ __forceinline__ unsigned xb_ld(unsigned* p)              { return __hip_atomic_load(p, __ATOMIC_RELAXED, __HIP_MEMORY_SCOPE_AGENT); }
__device__ __forceinline__ unsigned xb_add(unsigned* p, unsigned v) { return __hip_atomic_fetch_add(p, v, __ATOMIC_RELAXED, __HIP_MEMORY_SCOPE_AGENT); }
__device__ __forceinline__ unsigned xb_xcc_id() { return (unsigned)__builtin_amdgcn_s_getreg((3 << 11) | 20) & 0xFu; }
#define XB_SPIN(cond, bar) do { unsigned _sp = 0; while (cond) { __builtin_amdgcn_s_sleep(1); \
    if ((++_sp & 255u) == 0u) { if (xb_ld(&(bar)[XB_TMO])) break; if (_sp > XB_SPIN_CAP) { atomicAdd(&(bar)[XB_TMO], 1u); break; } } } } while (0)
struct XcdBarrier { unsigned* bar; unsigned x; volatile LAS unsigned* st; };
__device__ __forceinline__ XcdBarrier xcd_barrier_post(unsigned* bar, volatile LAS unsigned* st) {
    XcdBarrier b; b.bar = bar; b.x = xb_xcc_id(); b.st = st;
    if (threadIdx.x == 0) (void)xb_add(&bar[XB_XCNT(b.x)], 1u);
    return b;
}
__device__ __forceinline__ void xcd_barrier_complete(unsigned* bar, unsigned x, unsigned& nloc, unsigned& nx) {
    const unsigned G = gridDim.x * gridDim.y * gridDim.z;
    unsigned sum, cnt, mine, sp = 0u;
    for (;;) {
        sum = 0u; cnt = 0u; mine = 0u;
#pragma unroll
        for (unsigned j = 0; j < 16; ++j) { const unsigned c = xb_ld(&bar[XB_XCNT(j)]); sum += c; cnt += (c > 0u) ? 1u : 0u; mine = (j == x) ? c : mine; }
        if (sum == G) break;
        __builtin_amdgcn_s_sleep(1);
        if ((++sp & 255u) == 0u) { if (xb_ld(&bar[XB_TMO])) break; if (sp > XB_SPIN_CAP) { atomicAdd(&bar[XB_TMO], 1u); break; } }
    }
    nloc = mine > 0u ? mine : 1u; nx = cnt > 0u ? cnt : 1u;
}
__device__ __forceinline__ void xcd_barrier(const XcdBarrier& b) {
    asm volatile("s_waitcnt vmcnt(0)" ::: "memory");
    __syncthreads();
    if (threadIdx.x == 0) {
        unsigned* bar = b.bar;
        __builtin_amdgcn_s_waitcnt(0);
        unsigned nloc = b.st[0], nx = b.st[1];
        if (nloc == 0u) { xcd_barrier_complete(bar, b.x, nloc, nx); b.st[0] = nloc; b.st[1] = nx; }
        const unsigned old = xb_add(&bar[XB_XSUB(b.x)], 1u);
        const unsigned gen = old / nloc;
        if (old + 1u == (gen + 1u) * nloc) {
            __builtin_amdgcn_fence(__ATOMIC_RELEASE, "agent");
            asm volatile("s_waitcnt vmcnt(0)" ::: "memory");
            const unsigned og = xb_add(&bar[XB_TOP], 1u);
            const unsigned tg = og / nx;
            if (og + 1u == (tg + 1u) * nx) xb_add(&bar[XB_TOPGEN], 1u);
            else XB_SPIN(xb_ld(&bar[XB_TOPGEN]) == tg, bar);
            __builtin_amdgcn_fence(__ATOMIC_ACQUIRE, "agent");
            xb_add(&bar[XB_XGEN(b.x)], 1u);
            asm volatile("s_waitcnt vmcnt(0)" ::: "memory");
        } else {
            XB_SPIN(xb_ld(&bar[XB_XGEN(b.x)]) == gen, bar);
            __builtin_amdgcn_fence(__ATOMIC_ACQUIRE, "agent");
            asm volatile("s_waitcnt vmcnt(0)" ::: "memory");
        }
    }
    __syncthreads();
}

struct Frame {
    LAS unsigned char* lds;
    volatile LAS unsigned* MISC;
    int tid, lane, wave, vcu, G;
    const void* const* in_;
};
__device__ __forceinline__ float wave_sum(float v) {
#pragma unroll
    for (int o = 1; o < 64; o <<= 1) v += __shfl_xor(v, o);
    return v;
}
struct ListEnt { int tok; float gw; float rs; int pad; };
namespace ep {
using pg8::f32x4; using pg8::u32x4; using pg8::u32x2; using pg8::Unit; using pg8::pack8; using pg8::bf16_t; using pg8::cvt_pk_bf16;
typedef const f32x4 (&Acc)[2][2][4][2];
__device__ __forceinline__ float sumsq8(const f32x4 a, const f32x4 b) { return ((a[0] * a[0] + a[1] * a[1]) + (a[2] * a[2] + a[3] * a[3])) + ((b[0] * b[0] + b[1] * b[1]) + (b[2] * b[2] + b[3] * b[3])); }
__device__ __forceinline__ float quad_sum(float s) { s += __shfl_xor(s, 16); s += __shfl_xor(s, 32); return s; }
__device__ __forceinline__ float rstd_of(float ssq, float inv_n) { return 1.0f / sqrtf(ssq * inv_n + RMS_EPS); }
template <int NS> __device__ __forceinline__ float ssq_sum(const float* part, size_t grow, int fq) {
    float s = 0.f;
    if (4 * fq < NS) { const f32x4 v = *(const f32x4*)(part + grow * NS + 4 * fq); s = (v[0] + v[1]) + (v[2] + v[3]); }
    return quad_sum(s);
}
__device__ __forceinline__ void rope_store(const f32x4 x1, const f32x4 x2, const float* cs, bf16_t* p1, bf16_t* p2) {
    const f32x4 a = *(const f32x4*)cs, b = *(const f32x4*)(cs + 4);
    const float c0 = a[0], s0 = a[1], c1 = a[2], s1 = a[3], c2 = b[0], s2 = b[1], c3 = b[2], s3 = b[3];
    u32x2 w1, w2;
    w1.x = cvt_pk_bf16(x1[0] * c0 - x2[0] * s0, x1[1] * c1 - x2[1] * s1); w1.y = cvt_pk_bf16(x1[2] * c2 - x2[2] * s2, x1[3] * c3 - x2[3] * s3);
    w2.x = cvt_pk_bf16(x2[0] * c0 + x1[0] * s0, x2[1] * c1 + x1[1] * s1); w2.y = cvt_pk_bf16(x2[2] * c2 + x1[2] * s2, x2[3] * c3 + x1[3] * s3);
    *(u32x2*)p1 = w1; *(u32x2*)p2 = w2;
}
#define EP_ROWS for (int ai = 0; ai < 2; ++ai) _Pragma("unroll") for (int m = 0; m < 4; ++m)
#define EP_GROW (u.pm * 256 + ai * 128 + wr * 64 + m * 16 + fr)

struct EpiIn0 {
    bf16_t *FQ, *CKV, *CQ, *KPE; float* FL; float *pq, *pkv; const float* CSM;
    __device__ __forceinline__ void operator()(Acc acc, const Unit& u, int wr, int wc, int fr, int fq) const {
        const int cw = wc * 32 + fq * 8;
        if (u.pn < 6) {
#pragma unroll
            for (int bj = 0; bj < 2; ++bj) { const int cb = u.pn * 256 + bj * 128; bf16_t* dst = FQ + (size_t)(cb >> 9) * ((size_t)NTOK * 512); const int c = (cb + cw) & 511; const float sc = cb < 512 ? C2_FOX : 1.0f;
#pragma unroll
                EP_ROWS { const size_t grow = EP_GROW; *(u32x4*)(dst + grow * 512 + c) = pack8(acc[ai][bj][m][0] * sc, acc[ai][bj][m][1] * sc); } }
        } else if (u.pn == 6) {
#pragma unroll
            EP_ROWS { const size_t grow = EP_GROW; float s = 0.f;
#pragma unroll
                for (int bj = 0; bj < 2; ++bj) { const f32x4 v0 = acc[ai][bj][m][0], v1 = acc[ai][bj][m][1]; *(u32x4*)(CKV + grow * 256 + bj * 128 + cw) = pack8(v0, v1); s += sumsq8(v0, v1); }
                s = quad_sum(s); if (fq == 0) pkv[grow * 4 + wc] = s; }
        } else if (u.pn == 7) {
#pragma unroll
            EP_ROWS { const size_t grow = EP_GROW; float s = 0.f;
#pragma unroll
                for (int bj = 0; bj < 2; ++bj) { const f32x4 v0 = acc[ai][bj][m][0], v1 = acc[ai][bj][m][1]; *(u32x4*)(CQ + grow * 384 + bj * 128 + cw) = pack8(v0, v1); s += sumsq8(v0, v1); }
                s = quad_sum(s); if (fq == 0) pq[grow * 8 + wc] = s; }
        } else {
#pragma unroll
            EP_ROWS { const size_t grow = EP_GROW; const f32x4 v0 = acc[ai][0][m][0], v1 = acc[ai][0][m][1]; *(u32x4*)(CQ + grow * 384 + 256 + cw) = pack8(v0, v1);
                const float s = quad_sum(sumsq8(v0, v1)); if (fq == 0) pq[grow * 8 + 4 + wc] = s; }
            if (wc == 0) {
#pragma unroll
                EP_ROWS { const size_t grow = EP_GROW; rope_store(acc[ai][1][m][0], acc[ai][1][m][1], CSM + (grow * 16 + 4 * fq) * 2, KPE + grow * 32 + 4 * fq, KPE + grow * 32 + 16 + 4 * fq); if (m & 1) asm volatile("" ::: "memory"); }
            } else if (wc == 1 && fq == 0) {
#pragma unroll
                EP_ROWS { const size_t grow = EP_GROW; *(f32x4*)(FL + grow * 8) = acc[ai][1][m][0]; *(f32x4*)(FL + grow * 8 + 4) = acc[ai][1][m][1]; }
            }
        }
    }
};
struct EpiQup {
    bf16_t* MQ; const float* pq; const float* CSM;
    __device__ __forceinline__ void operator()(Acc acc, const Unit& u, int wr, int wc, int fr, int fq) const {
        float rqv[2][4];
#pragma unroll
        EP_ROWS { rqv[ai][m] = ssq_sum<8>(pq, EP_GROW, fq); }
        asm volatile("" ::: "memory");
#pragma unroll
        EP_ROWS { const size_t grow = EP_GROW; const float rq = rstd_of(rqv[ai][m], 1.0f / 384.0f) * C2_MLA;
#pragma unroll
            for (int bj = 0; bj < 2; ++bj) { const int col8 = u.pn * 256 + bj * 128 + wc * 32 + fq * 8; const f32x4 v0 = acc[ai][bj][m][0] * rq, v1 = acc[ai][bj][m][1] * rq;
                if (u.pn < 2) { const int h = col8 >> 6, d = col8 & 63; *(u32x4*)(MQ + grow * 768 + h * 96 + d) = pack8(v0, v1); }
                else { const int j = col8 - 512, h = j >> 5, g = (j & 31) >> 3; rope_store(v0, v1, CSM + (grow * 16 + 4 * g) * 2, MQ + grow * 768 + h * 96 + 64 + 4 * g, MQ + grow * 768 + h * 96 + 80 + 4 * g); } }
            asm volatile("" ::: "memory"); }
    }
};
struct EpiKVup {
    bf16_t* MKV; const float* pkv;
    __device__ __forceinline__ void operator()(Acc acc, const Unit& u, int wr, int wc, int fr, int fq) const {
        float rkv[2][4];
#pragma unroll
        EP_ROWS { rkv[ai][m] = ssq_sum<4>(pkv, EP_GROW, fq); }
        asm volatile("" ::: "memory");
#pragma unroll
        EP_ROWS { const size_t grow = EP_GROW; const float rk = rstd_of(rkv[ai][m], 1.0f / 256.0f);
#pragma unroll
            for (int bj = 0; bj < 2; ++bj) { const int col8 = u.pn * 256 + bj * 128 + wc * 32 + fq * 8; *(u32x4*)(MKV + grow * 1024 + col8) = pack8(acc[ai][bj][m][0] * rk, acc[ai][bj][m][1] * rk); } }
    }
};
struct EpiRes {
    const float* base; float* out; bf16_t* xb; float* part;
    __device__ __forceinline__ void operator()(Acc acc, const Unit& u, int wr, int wc, int fr, int fq) const {
#pragma unroll
        EP_ROWS { const size_t grow = EP_GROW; float s = 0.f;
#pragma unroll
            for (int bj = 0; bj < 2; ++bj) { const size_t off = grow * 1024 + u.pn * 256 + bj * 128 + wc * 32 + fq * 8;
                const f32x4 h0 = *(const f32x4*)(base + off) + acc[ai][bj][m][0], h1 = *(const f32x4*)(base + off + 4) + acc[ai][bj][m][1];
                *(f32x4*)(out + off) = h0; *(f32x4*)(out + off + 4) = h1; *(u32x4*)(xb + off) = pack8(h0, h1); s += sumsq8(h0, h1); }
            if (part) { s = quad_sum(s); if (fq == 0) part[grow * 16 + u.pn * 4 + wc] = s; } if (m & 1) asm volatile("" ::: "memory"); }
    }
};
__device__ __forceinline__ f32x4 silu_mul(const f32x4 g, const f32x4 v) {
    f32x4 r;
#pragma unroll
    for (int i = 0; i < 4; ++i) r[i] = g[i] * v[i] * __builtin_amdgcn_rcpf(1.0f + __builtin_amdgcn_exp2f(-g[i] * LOG2E));
    return r;
}
struct EpiGU {
    bf16_t* HID; const float* part;
    __device__ __forceinline__ void operator()(Acc acc, const Unit& u, int wr, int wc, int fr, int fq) const {
        float rsv[2][4];
#pragma unroll
        EP_ROWS { rsv[ai][m] = ssq_sum<16>(part, EP_GROW, fq); }
        asm volatile("" ::: "memory");
#pragma unroll
        EP_ROWS { const size_t grow = EP_GROW; const float rs = rstd_of(rsv[ai][m], 1.0f / 1024.0f);
            const f32x4 h0 = silu_mul(acc[ai][0][m][0] * rs, acc[ai][1][m][0] * rs), h1 = silu_mul(acc[ai][0][m][1] * rs, acc[ai][1][m][1] * rs);
            *(u32x4*)(HID + grow * DFF + u.pn * 128 + wc * 32 + fq * 8) = pack8(h0, h1); }
    }
};
struct EpiIn1 {
    bf16_t *SQ, *SK, *SV, *GB, *U; const float* part; const float* CSS;
    __device__ __forceinline__ void operator()(Acc acc, const Unit& u, int wr, int wc, int fr, int fq) const {
        float rsv[2][4];
#pragma unroll
        EP_ROWS { rsv[ai][m] = ssq_sum<16>(part, EP_GROW, fq); }
        asm volatile("" ::: "memory");
#pragma unroll
        EP_ROWS { const size_t grow = EP_GROW; const float rs = rstd_of(rsv[ai][m], 1.0f / 1024.0f);
            if (u.pn < 2) {
#pragma unroll
                for (int bj = 0; bj < 2; ++bj) { const int col8 = u.pn * 256 + bj * 128 + wc * 32 + fq * 8, hd = col8 >> 6, g = (col8 & 63) >> 3; const float sc = rs * C2_SWA;
                    rope_store(acc[ai][bj][m][0] * sc, acc[ai][bj][m][1] * sc, CSS + (grow * 32 + 4 * g) * 2, SQ + grow * 512 + hd * 64 + 4 * g, SQ + grow * 512 + hd * 64 + 32 + 4 * g); }
            } else if (u.pn == 2) {
                { const int col8 = wc * 32 + fq * 8, hd = col8 >> 6, g = (col8 & 63) >> 3;
                  rope_store(acc[ai][0][m][0] * rs, acc[ai][0][m][1] * rs, CSS + (grow * 32 + 4 * g) * 2, SK + grow * 128 + hd * 64 + 4 * g, SK + grow * 128 + hd * 64 + 32 + 4 * g); }
                *(u32x4*)(SV + grow * 128 + wc * 32 + fq * 8) = pack8(acc[ai][1][m][0] * rs, acc[ai][1][m][1] * rs);
            } else if (u.pn < 5) {
#pragma unroll
                for (int bj = 0; bj < 2; ++bj) *(u32x4*)(GB + grow * 512 + (u.pn - 3) * 256 + bj * 128 + wc * 32 + fq * 8) = pack8(acc[ai][bj][m][0] * rs, acc[ai][bj][m][1] * rs);
            } else {
                const float r2 = rs * rs;
                *(u32x4*)(U + grow * 512 + (u.pn - 5) * 128 + wc * 32 + fq * 8) = pack8(acc[ai][0][m][0] * acc[ai][1][m][0] * r2, acc[ai][0][m][1] * acc[ai][1][m][1] * r2);
            }
            asm volatile("" ::: "memory"); }
    }
};
struct EpiMoe1 {
    bf16_t* HID1; const ListEnt* list;
    __device__ __forceinline__ void operator()(Acc acc, const Unit& u, int wr, int wc, int fr, int fq) const {
        float rsv[2][4];
#pragma unroll
        EP_ROWS { const int lrow = ai * 128 + wr * 64 + m * 16 + fr; rsv[ai][m] = 0.f; if (lrow < u.nv) rsv[ai][m] = list[(size_t)u.e * NTOK + u.s0 + lrow].rs; }
        asm volatile("" ::: "memory");
#pragma unroll
        EP_ROWS { const int lrow = ai * 128 + wr * 64 + m * 16 + fr; const float rs = rsv[ai][m];
            const f32x4 h0 = silu_mul(acc[ai][0][m][0] * rs, acc[ai][1][m][0] * rs), h1 = silu_mul(acc[ai][0][m][1] * rs, acc[ai][1][m][1] * rs);
            *(u32x4*)(HID1 + ((size_t)u.pm * 256 + lrow) * DFF + u.pn * 128 + wc * 32 + fq * 8) = pack8(h0, h1); }
    }
};
struct EpiMoe2 {
    float* out; const ListEnt* list;
    __device__ __forceinline__ void operator()(Acc acc, const Unit& u, int wr, int wc, int fr, int fq) const {
#pragma unroll
        EP_ROWS { const int lrow = ai * 128 + wr * 64 + m * 16 + fr;
            if (lrow < u.nv) { const ListEnt en = list[(size_t)u.e * NTOK + u.s0 + lrow];
#pragma unroll
                for (int bj = 0; bj < 2; ++bj) { float* p = out + (size_t)en.tok * 1024 + u.pn * 256 + bj * 128 + wc * 32 + fq * 8;
                    *(f32x4*)p = *(const f32x4*)p + acc[ai][bj][m][0] * en.gw; *(f32x4*)(p + 4) = *(const f32x4*)(p + 4) + acc[ai][bj][m][1] * en.gw; } }
            if (m & 1) asm volatile("" ::: "memory"); }
    }
};
#undef EP_ROWS
#undef EP_GROW
}
__device__ const float INV_FREQ64[32] = {1.000000000e+00f, 7.498942614e-01f, 5.623413324e-01f, 4.216965139e-01f, 3.162277639e-01f, 2.371373773e-01f, 1.778279394e-01f, 1.333521307e-01f,
    1.000000015e-01f, 7.498941571e-02f, 5.623413250e-02f, 4.216965288e-02f, 3.162277490e-02f, 2.371373773e-02f, 1.778279431e-02f, 1.333521493e-02f, 9.999999776e-03f, 7.498941850e-03f,
    5.623413250e-03f, 4.216964822e-03f, 3.162277630e-03f, 2.371373586e-03f, 1.778279431e-03f, 1.333521446e-03f, 1.000000047e-03f, 7.498942432e-04f, 5.623413017e-04f, 4.216965172e-04f,
    3.162277571e-04f, 2.371373703e-04f, 1.778279402e-04f, 1.333521504e-04f};

struct MapId { const float* W; int ldw_; __device__ __forceinline__ const float* col(int n) const { return W + n; } __device__ __forceinline__ int ldw() const { return ldw_; } };
struct MapIn0 { const float* W; __device__ __forceinline__ int ldw() const { return 2216; }
    __device__ __forceinline__ const float* col(int n) const { int s;
        if (n < 1536) s = n; else if (n < 1792) s = 1928 + (n - 1536); else if (n < 2176) s = 1544 + (n - 1792);
        else if (n < 2208) { const int j = n - 2176, g = j >> 3, e = j & 7; s = 2184 + (e < 4 ? 4 * g + e : 16 + 4 * g + (e - 4)); }
        else if (n < 2216) s = 1536 + (n - 2208); else return nullptr;
        return W + s; } };
struct MapQup { const float* W; __device__ __forceinline__ int ldw() const { return 768; }
    __device__ __forceinline__ const float* col(int n) const { int s;
        if (n < 512) { s = (n >> 6) * 96 + (n & 63); } else { const int j = n - 512, h = j >> 5, g = (j & 31) >> 3, e = j & 7; s = h * 96 + 64 + (e < 4 ? 4 * g + e : 16 + 4 * g + (e - 4)); }
        return W + s; } };
struct MapGU { const float* Wg; const float* Wu; __device__ __forceinline__ int ldw() const { return DFF; }
    __device__ __forceinline__ const float* col(int n) const { const int pn = n >> 8, j = n & 255; return j < 128 ? Wg + 128 * pn + j : Wu + 128 * pn + (j - 128); } };
struct MapIn1 { const float* W; __device__ __forceinline__ int ldw() const { return 2304; }
    __device__ __forceinline__ const float* col(int n) const { int s;
        if (n < 640) { const int hd = n >> 6, j = n & 63, g = j >> 3, e = j & 7; s = hd * 64 + (e < 4 ? 4 * g + e : 32 + 4 * g + (e - 4)); }
        else if (n < 1280) s = n; else { const int u = (n - 1280) >> 8, j = (n - 1280) & 255; s = j < 128 ? 1280 + 128 * u + j : 1792 + 128 * u + (j - 128); }
        return W + s; } };
template <class Map>
__device__ __forceinline__ void tr_item(const Map& M, const float* gain, int K, int ND, bf16* WT, LAS float* scr, int item, int lane) {
    const int nblk = ND / 32, kb = item / nblk, nb = item % nblk, k0 = 64 * kb, n0 = 32 * nb;
    const float* cp = M.col(n0 + (lane & 31)); const int ldw = M.ldw();
#pragma unroll 8
    for (int i = 0; i < 32; ++i) { const int kk = 2 * i + (lane >> 5); float v = 0.f; if (cp) { v = cp[(size_t)(k0 + kk) * ldw]; if (gain) v *= gain[k0 + kk]; } scr[kk * 33 + (lane & 31)] = v; }
    LDS_WAIT(); asm volatile("" ::: "memory");
    const int c = lane & 7;
#pragma unroll
    for (int j = 0; j < 4; ++j) { const int n = (lane >> 3) + 8 * j; const LAS float* s = scr + (8 * c) * 33 + n;
        v4u o; o.x = pk2(s[0 * 33], s[1 * 33]); o.y = pk2(s[2 * 33], s[3 * 33]); o.z = pk2(s[4 * 33], s[5 * 33]); o.w = pk2(s[6 * 33], s[7 * 33]);
        *(GAS v4u*)(WT + (size_t)(n0 + n) * K + k0 + 8 * c) = o; }
    LDS_WAIT(); asm volatile("" ::: "memory");
}

struct Args { const float* in[25]; float* out; unsigned char* ws; int ph_lo, ph_hi; };
#define P0_IN(i) (*(const float* const __attribute__((address_space(4)))*)((__attribute__((address_space(4))) const unsigned char*)__builtin_amdgcn_kernarg_segment_ptr() + 8 * (i)))
__device__ __forceinline__ void p0_prologue(Frame& F, unsigned char* ws) {
    LAS float* scr = (LAS float*)(F.lds + RING_OFF + F.wave * 16384);
    const int gw = F.vcu * NWAVES + F.wave, NGW = F.G * NWAVES;
    constexpr int I_IN0 = 16 * 72, I_QUP = 6 * 24, I_KVUP = 4 * 32, I_OUT = 16 * 32, I_GU = 16 * 224, I_D = 56 * 32;
    constexpr int NITEMS = I_IN0 + I_QUP + I_KVUP + I_OUT + I_GU + I_D + I_IN0 + I_OUT + 8 * I_GU + 8 * I_D;
    for (int it = gw; it < NITEMS; it += NGW) {
        int r = it;
        if (r < I_IN0) { tr_item(MapIn0{P0_IN(3)}, (const float*)nullptr, 1024, 2304, (bf16*)(ws + WS_W_IN0), scr, r, F.lane); continue; } r -= I_IN0;
        if (r < I_QUP) { tr_item(MapQup{P0_IN(6)}, P0_IN(5), 384, 768, (bf16*)(ws + WS_W_QUP), scr, r, F.lane); continue; } r -= I_QUP;
        if (r < I_KVUP) { tr_item(MapId{P0_IN(8), 1024}, P0_IN(7), 256, 1024, (bf16*)(ws + WS_W_KVUP), scr, r, F.lane); continue; } r -= I_KVUP;
        if (r < I_OUT) { tr_item(MapId{P0_IN(9), 1024}, (const float*)nullptr, 1024, 1024, (bf16*)(ws + WS_W_OUT0), scr, r, F.lane); continue; } r -= I_OUT;
        if (r < I_GU) { tr_item(MapGU{P0_IN(11), P0_IN(12)}, P0_IN(10), 1024, 7168, (bf16*)(ws + WS_W_GU0), scr, r, F.lane); continue; } r -= I_GU;
        if (r < I_D) { tr_item(MapId{P0_IN(13), 1024}, (const float*)nullptr, DFF, 1024, (bf16*)(ws + WS_W_D0), scr, r, F.lane); continue; } r -= I_D;
        if (r < I_IN0) { tr_item(MapIn1{P0_IN(15)}, P0_IN(14), 1024, 2304, (bf16*)(ws + WS_W_IN1), scr, r, F.lane); continue; } r -= I_IN0;
        if (r < I_OUT) { tr_item(MapId{P0_IN(18), 1024}, (const float*)nullptr, 1024, 1024, (bf16*)(ws + WS_W_OUT1), scr, r, F.lane); continue; } r -= I_OUT;
        if (r < 8 * I_GU) { const int e = r / I_GU; r -= e * I_GU; const size_t wo = (size_t)e * 1024 * DFF;
            tr_item(MapGU{P0_IN(21) + wo, P0_IN(22) + wo}, P0_IN(19), 1024, 7168, (bf16*)(ws + WS_WMOE_GU) + (size_t)e * 7168 * 1024, scr, r, F.lane); continue; } r -= 8 * I_GU;
        { const int e = r / I_D; r -= e * I_D; tr_item(MapId{P0_IN(23) + (size_t)e * DFF * 1024, 1024}, (const float*)nullptr, DFF, 1024, (bf16*)(ws + WS_WMOE_D) + (size_t)e * 1024 * DFF, scr, r, F.lane); }
    }
    const int* pos = (const int*)P0_IN(1);
    const int gt = F.vcu * (NWAVES * 64) + F.tid, NGT = F.G * NWAVES * 64;
    for (int idx = gt; idx < NTOK * 48; idx += NGT) {
        const int tok = idx / 48, j = idx % 48; const bool m = j < 16; const int i = m ? j : j - 16;
        const float ang = (float)pos[tok] * INV_FREQ64[m ? 2 * i : i];
        const double a = (double)ang; const double n = rint(a * 0.15915494309189535); double r = fma(-n, 6.283185307179586, a); r = fma(-n, 2.4492935982947064e-16, r);
        f32x2 cs; cs.x = (float)cos(r); cs.y = (float)sin(r);
        if (m) *(f32x2*)(ws + WS_CSM + ((size_t)tok * 16 + i) * 8) = cs; else *(f32x2*)(ws + WS_CSS + ((size_t)tok * 32 + i) * 8) = cs;
    }
    const float* g0 = P0_IN(2);
    for (int m = gw; m < NTOK; m += NGW) {
        const GAS f32x4* xr = (const GAS f32x4*)(P0_IN(0) + (size_t)m * DM) + F.lane;
        f32x4 v[4]; float s = 0.f;
#pragma unroll
        for (int j = 0; j < 4; ++j) { v[j] = xr[64 * j]; s += (v[j].x * v[j].x + v[j].y * v[j].y) + (v[j].z * v[j].z + v[j].w * v[j].w); }
        const float rstd = 1.f / sqrtf(wave_sum(s) * (1.f / DM) + RMS_EPS);
        GAS unsigned long long* o8 = (GAS unsigned long long*)((bf16*)(ws + WS_XB) + (size_t)m * DM) + F.lane;
#pragma unroll
        for (int j = 0; j < 4; ++j) { const f32x4 g = *((const f32x4*)g0 + F.lane + 64 * j);
            o8[64 * j] = (unsigned long long)pk2(v[j].x * rstd * g.x, v[j].y * rstd * g.y) | ((unsigned long long)pk2(v[j].z * rstd * g.z, v[j].w * rstd * g.w) << 32); }
    }
}

__device__ __forceinline__ void fox_cumsum(Frame& F, const float* FL, const float* bforget, bf16* KB, int b, int h) {
    const float bh = bforget[h]; const int t0 = 16 * F.tid;
    float ls[16]; double loc = 0.0;
#pragma unroll
    for (int i = 0; i < 16; ++i) { const float z = FL[((size_t)(b * SEQ + t0 + i)) * 8 + h] + bh; const float l = fminf(z, 0.f) - log1pf(expf(-fabsf(z))); loc += (double)l; ls[i] = (float)loc; }
    double inc = loc;
#pragma unroll
    for (int o = 1; o < 64; o <<= 1) { const double t = __shfl_up(inc, o); if (F.lane >= o) inc += t; }
    LAS double* wt = (LAS double*)(F.lds + RING_OFF);
    if (F.lane == 63) wt[F.wave] = inc;
    __syncthreads();
    double base = 0.0;
#pragma unroll
    for (int w = 0; w < 8; ++w) if (w < F.wave) base += wt[w];
    const double excl = base + inc - loc;
#pragma unroll
    for (int i = 0; i < 16; ++i) {
        const float v = -(float)(excl + (double)ls[i]) * LOG2E;
        const unsigned hi = f2bf(v); const float r1 = v - bf2f(hi); const unsigned mid = f2bf(r1); const float r2 = r1 - bf2f(mid); const unsigned lo = f2bf(r2);
        v4u w0; w0.x = hi | (mid << 16); w0.y = lo; w0.z = 0u; w0.w = 0u; const v4u z4 = {0u, 0u, 0u, 0u};
        bf16* dst = KB + ((size_t)(b * SEQ + t0 + i) * 8 + h) * 16;
        *(v4u*)dst = w0; *(v4u*)(dst + 8) = z4;
    }
    __syncthreads();
}

__device__ __forceinline__ void conv_phase(Frame& F, const bf16* GB, const bf16* U, const float* cw, bf16* MIX1) {
    const int gt = F.vcu * (NWAVES * 64) + F.tid, NGT = F.G * NWAVES * 64;
    for (int idx = gt; idx < NTOK * 64; idx += NGT) {
        const int tok = idx >> 6, c8 = (idx & 63) * 8, t = tok & (SEQ - 1);
        const v4u gb = *(const v4u*)(GB + (size_t)tok * 512 + c8), u2 = *(const v4u*)(U + (size_t)tok * 512 + c8);
        v4u u1 = {0u, 0u, 0u, 0u}, u0 = {0u, 0u, 0u, 0u};
        if (t >= 1) u1 = *(const v4u*)(U + (size_t)(tok - 1) * 512 + c8);
        if (t >= 2) u0 = *(const v4u*)(U + (size_t)(tok - 2) * 512 + c8);
        float o[8];
#pragma unroll
        for (int e = 0; e < 8; ++e) { const int sh = (e & 1) * 16; const unsigned m = 0xffffu;
            const float g = bf2f((gb[e >> 1] >> sh) & m), a0 = bf2f((u0[e >> 1] >> sh) & m), a1 = bf2f((u1[e >> 1] >> sh) & m), a2 = bf2f((u2[e >> 1] >> sh) & m);
            o[e] = g * (cw[c8 + e] * a0 + cw[512 + c8 + e] * a1 + cw[1024 + c8 + e] * a2); }
        v4u w; w.x = pk2(o[0], o[1]); w.y = pk2(o[2], o[3]); w.z = pk2(o[4], o[5]); w.w = pk2(o[6], o[7]);
        *(v4u*)(MIX1 + (size_t)tok * 1024 + 512 + c8) = w;
    }
}

__device__ __forceinline__ void router_phase(Frame& F, const float* h3, const float* gnorm, const float* wr, ListEnt* LIST, gu32* ctl) {
    float wq[4][4][8];
#pragma unroll
    for (int j = 0; j < 4; ++j)
#pragma unroll
        for (int e = 0; e < 4; ++e) { const int k = 256 * j + 4 * F.lane + e; const float g = gnorm[k];
#pragma unroll
            for (int x = 0; x < 8; ++x) wq[j][e][x] = g * wr[k * 8 + x]; }
    LAS float* info = (LAS float*)(F.lds + RING_OFF);
    LAS unsigned* cl = (LAS unsigned*)(F.lds + RING_OFF + 8192);
    if (F.tid < 32) cl[F.tid] = 0u;
    __syncthreads();
    const int row0 = (int)blockIdx.x * 128;
    for (int j = 0; j < 16; ++j) {
        const int lr = F.wave * 16 + j, row = row0 + lr;
        const GAS f32x4* xr = (const GAS f32x4*)(h3 + (size_t)row * DM) + F.lane;
        float s = 0.f, lg[8];
#pragma unroll
        for (int x = 0; x < 8; ++x) lg[x] = 0.f;
#pragma unroll
        for (int q = 0; q < 4; ++q) { const f32x4 v = xr[64 * q]; s += (v.x * v.x + v.y * v.y) + (v.z * v.z + v.w * v.w);
#pragma unroll
            for (int x = 0; x < 8; ++x) lg[x] += (v.x * wq[q][0][x] + v.y * wq[q][1][x]) + (v.z * wq[q][2][x] + v.w * wq[q][3][x]); }
        const float rstd = 1.f / sqrtf(wave_sum(s) * (1.f / DM) + RMS_EPS);
#pragma unroll
        for (int x = 0; x < 8; ++x) lg[x] = wave_sum(lg[x]) * rstd;
        int i0 = 0; float m0 = lg[0];
#pragma unroll
        for (int x = 1; x < 8; ++x) if (lg[x] > m0) { m0 = lg[x]; i0 = x; }
        int i1 = -1; float m1 = -INFINITY;
#pragma unroll
        for (int x = 0; x < 8; ++x) if (x != i0 && lg[x] > m1) { m1 = lg[x]; i1 = x; }
        const float w1 = 1.0f / (1.0f + expf(m0 - m1)), w0 = 1.0f - w1;
        if (F.lane == 0) { info[lr * 8 + 0] = __int_as_float(i0); info[lr * 8 + 1] = __int_as_float(i1); info[lr * 8 + 2] = w0; info[lr * 8 + 3] = w1; info[lr * 8 + 4] = rstd; }
    }
    __syncthreads();
    int e = 0, sl = 0; const int lr = F.tid >> 1, k = F.tid & 1;
    if (F.tid < 256) { e = __float_as_int(info[lr * 8 + k]); sl = (int)atomicAdd((unsigned*)(cl + k * 8 + e), 1u); }
    __syncthreads();
    if (F.tid < 16) cl[16 + F.tid] = __hip_atomic_fetch_add(ctl + CW_CNT + 64 * F.tid, cl[F.tid], RLX_AGENT);
    __syncthreads();
    if (F.tid < 256) { const int slot = (int)cl[16 + k * 8 + e] + sl; ListEnt en; en.tok = row0 + lr; en.gw = info[lr * 8 + 2 + k]; en.rs = info[lr * 8 + 4]; en.pad = 0;
        LIST[((size_t)(k * 8 + e)) * NTOK + slot] = en; }
    __syncthreads();
}

struct MoeOrder {
    pg8::StaticOrder so; int nN; const LAS int* tab; const ListEnt* list;
    __device__ __forceinline__ void init(LAS int* tab_, const gu32* ctl, int rank, const ListEnt* list_, int nN_, int G, int c) {
        list = list_; nN = nN_; tab = tab_;
        __syncthreads();
        if (threadIdx.x == 0) { int acc = 0;
            for (int e = 0; e < 8; ++e) { const int ce = (int)__hip_atomic_load(ctl + CW_CNT + 64 * (rank * 8 + e), RLX_AGENT); tab_[e] = ce; tab_[8 + e] = acc; acc += (ce + 255) >> 8; }
            tab_[16] = acc; }
        __syncthreads();
        int tot = __builtin_amdgcn_readfirstlane(tab_[16]); if (tot > MOE_CAP) tot = MOE_CAP;
        so.init(tot, nN, G, c);
    }
    __device__ __forceinline__ bool next(int i, pg8::Unit& u) const {
        int lp, pn; if (!so.tile(i, lp, pn)) return false;
        int e = 0;
#pragma unroll
        for (int x = 1; x < 8; ++x) if (lp >= __builtin_amdgcn_readfirstlane(tab[8 + x])) e = x;
        const int j = lp - __builtin_amdgcn_readfirstlane(tab[8 + e]); int nv = __builtin_amdgcn_readfirstlane(tab[e]) - 256 * j; if (nv > 256) nv = 256;
        u.pa = lp; u.pb = e * nN + pn; u.pm = lp; u.pn = pn; u.e = e; u.nv = nv; u.s0 = 256 * j; return true;
    }
    __device__ __forceinline__ void fill(const pg8::Unit& u, LAS unsigned* dst, int wid, int lane) const {
        if (wid < 4) __builtin_amdgcn_global_load_lds((const unsigned*)&list[(size_t)u.e * NTOK + u.s0 + wid * 64 + lane].tok, dst + wid * 64, 4, 0, 0);
    }
};
constexpr int NPH = 16;
__device__ __forceinline__ bool in_phase(int k, int lo, int hi) { asm volatile("" : "+s"(lo), "+s"(hi)); return lo <= k && k < hi; }
static_assert(sizeof(Args) == 25 * 8 + 8 + 8 + 8, "Args has no padding");
__global__ void __launch_bounds__(NWAVES * 64, 2) skel_fwd(Args args) {
    extern __shared__ __attribute__((aligned(16))) unsigned char lds[];
    Frame F;
    F.lds = (LAS unsigned char*)lds;
    F.MISC = (volatile LAS unsigned*)(F.lds + MISC_OFF);
#define FRAME_TID() do { int t_ = threadIdx.x; asm volatile("" : "+v"(t_)); F.tid = t_; F.lane = t_ & 63; F.wave = __builtin_amdgcn_readfirstlane(t_ >> 6); \
        int g_ = gridDim.x, bx_ = blockIdx.x; asm volatile("" : "+s"(g_), "+s"(bx_)); F.G = g_; F.vcu = (g_ % 8 == 0) ? (bx_ % 8) * (g_ / 8) + bx_ / 8 : bx_; } while (0)
    FRAME_TID();
    typedef __attribute__((address_space(4))) const unsigned char* kptr_t;
#define KARG() ({ kptr_t kp_ = (kptr_t)__builtin_amdgcn_kernarg_segment_ptr(); asm volatile("" : "+s"(kp_)); kp_; })
#define ARG_IN(i) (*(const float* const __attribute__((address_space(4)))*)(KARG() + 8 * (i)))
#define ARG_OUT() (*(float* const __attribute__((address_space(4)))*)(KARG() + 200))
#define ARG_WS() (*(unsigned char* const __attribute__((address_space(4)))*)(KARG() + 208))
#define ARG_LO() (*(const int __attribute__((address_space(4)))*)(KARG() + 216))
#define ARG_HI() (*(const int __attribute__((address_space(4)))*)(KARG() + 220))
#define ws (ARG_WS())
#define FCTL ((gu32*)(ws + WS_CTL))
    for (int u = F.tid; u < (LDS_BYTES - LDSCTL_OFF) / 4; u += NWAVES * 64) ((LAS unsigned*)(F.lds + LDSCTL_OFF))[u] = 0u;
    __syncthreads();
    XcdBarrier bar = xcd_barrier_post((unsigned*)(FCTL + CW_BAR), F.MISC + 8);
    const int lo = ARG_LO(), hi = ARG_HI();
#ifndef PH_MASK
#define PH_MASK 0xFFFF
#endif
#define IN(k) (((PH_MASK >> (k)) & 1) && in_phase((k), lo, hi))
#define SEAM(k) do { if (IN(k) && IN((k) + 1)) xcd_barrier(bar); } while (0)
#define dob ((unsigned char*)ARG_OUT())
#define ssq_q ((float*)(ws + WS_PQ))
#define ssq_kv ((float*)(ws + WS_PKV))
#define ssq_h1 ((float*)(ws + WS_PH))
#define ssq_h2 ((float*)(ws + WS_PH))
#define XB ((bf16*)(ws + WS_XB))
#define bid ((int)blockIdx.x)

    if (IN(0)) { FRAME_TID(); p0_prologue(F, ws); }
    SEAM(0);
    if (IN(1)) { FRAME_TID();
        pg8::StaticOrder S; S.init(NTOK / 256, 9, F.G, bid);
        ep::EpiIn0 E{(bf16*)(dob + DO_FQ), (bf16*)(dob + DO_CKV), (bf16*)(ws + WS_CQ), (bf16*)(ws + WS_KPE), (float*)(ws + WS_FL), ssq_q, ssq_kv, (const float*)(ws + WS_CSM)};
        pg8::gemm_phase<ep::EpiIn0, pg8::StaticOrder, false>(F.lds + RING_OFF, XB, (const bf16*)(ws + WS_W_IN0), 1024, S, E);
    }
    SEAM(1);
    if (IN(2)) { FRAME_TID();
#ifndef P2_PARTS
#define P2_PARTS 7
#endif
        if ((P2_PARTS & 1) && F.vcu < 32) fox_cumsum(F, (const float*)(ws + WS_FL), ARG_IN(4), (bf16*)(dob + DO_KB), F.vcu >> 3, F.vcu & 7);
        if (P2_PARTS & 2) { pg8::StaticOrder S; S.init(NTOK / 256, 3, F.G, bid);
          ep::EpiQup E{(bf16*)(ws + WS_MQ), ssq_q, (const float*)(ws + WS_CSM)};
          pg8::gemm_phase<ep::EpiQup, pg8::StaticOrder, false>(F.lds + RING_OFF, (const bf16*)(ws + WS_CQ), (const bf16*)(ws + WS_W_QUP), 384, S, E); }
        if (P2_PARTS & 4) { pg8::StaticOrder S; S.init(NTOK / 256, 4, F.G, bid);
          ep::EpiKVup E{(bf16*)(ws + WS_MKV), ssq_kv};
          pg8::gemm_phase<ep::EpiKVup, pg8::StaticOrder, false>(F.lds + RING_OFF, (const bf16*)(dob + DO_CKV), (const bf16*)(ws + WS_W_KVUP), 256, S, E); }
    }
    SEAM(2);
    if (IN(3)) { FRAME_TID();
        const int bh = F.vcu >> 3, s = F.vcu & 7, b = bh >> 3, h = bh & 7; const size_t rb = (size_t)b * SEQ;
        bf16* MIX0 = (bf16*)(ws + WS_MIX0);
        { att::Ptrs A; const bf16* FQ = (const bf16*)(dob + DO_FQ); const bf16* FK = (const bf16*)(dob + DO_FK); const bf16* FV = (const bf16*)(dob + DO_FV); const bf16* KB = (const bf16*)(dob + DO_KB);
          A.Qm = FQ + rb * 512 + h * 64; A.qp = 512; A.Qx = nullptr; A.qxp = 0; A.Km = FK + rb * 512 + h * 64; A.kp = 512; A.Kx = KB + rb * 128 + h * 16; A.kxp = 128;
          A.V = FV + rb * 512 + h * 64; A.vp = 512; A.O = MIX0 + rb * 1024 + h * 64; A.op = 1024;
          for (int i = 0; i < 4; ++i) { const int qb = (i == 0) ? s : (i == 1) ? 15 - s : (i == 2) ? 16 + s : 31 - s; att::attn_unit<5, 0, true>(A, qb * 256, 0.f, (char*)lds + RING_OFF); } }
        { att::Ptrs A; const bf16* MQ = (const bf16*)(ws + WS_MQ); const bf16* MKV = (const bf16*)(ws + WS_MKV); const bf16* KPE = (const bf16*)(ws + WS_KPE);
          A.Qm = MQ + rb * 768 + h * 96; A.qp = 768; A.Qx = A.Qm + 64; A.qxp = 768; A.Km = MKV + rb * 1024 + h * 128; A.kp = 1024; A.Kx = KPE + rb * 32; A.kxp = 32;
          A.V = MKV + rb * 1024 + h * 128 + 64; A.vp = 1024; A.O = MIX0 + rb * 1024 + 512 + h * 64; A.op = 1024;
          for (int i = 0; i < 4; ++i) { const int qb = (i == 0) ? s : (i == 1) ? 15 - s : (i == 2) ? 16 + s : 31 - s; att::attn_unit<6, 0, false>(A, qb * 256, 0.f, (char*)lds + RING_OFF); } }
    }
    SEAM(3);
    if (IN(4)) { FRAME_TID();
        pg8::StaticOrder S; S.init(NTOK / 256, 4, F.G, bid);
        ep::EpiRes E{ARG_IN(0), ARG_OUT(), XB, ssq_h1};
        pg8::gemm_phase<ep::EpiRes, pg8::StaticOrder, false>(F.lds + RING_OFF, (const bf16*)(ws + WS_MIX0), (const bf16*)(ws + WS_W_OUT0), 1024, S, E);
    }
    SEAM(4);
    if (IN(5)) { FRAME_TID();
        pg8::StaticOrder S; S.init(NTOK / 256, 28, F.G, bid);
        ep::EpiGU E{(bf16*)(ws + WS_HID0), ssq_h1};
        pg8::gemm_phase<ep::EpiGU, pg8::StaticOrder, false>(F.lds + RING_OFF, XB, (const bf16*)(ws + WS_W_GU0), 1024, S, E);
    }
    SEAM(5);
    if (IN(6)) { FRAME_TID();
        pg8::StaticOrder S; S.init(NTOK / 256, 4, F.G, bid);
        ep::EpiRes E{ARG_OUT(), ARG_OUT(), XB, ssq_h2};
        pg8::gemm_phase<ep::EpiRes, pg8::StaticOrder, false>(F.lds + RING_OFF, (const bf16*)(ws + WS_HID0), (const bf16*)(ws + WS_W_D0), DFF, S, E);
    }
    SEAM(6);
    if (IN(7)) { FRAME_TID();
        pg8::StaticOrder S; S.init(NTOK / 256, 9, F.G, bid);
        ep::EpiIn1 E{(bf16*)(ws + WS_SQ), (bf16*)(ws + WS_SK), (bf16*)(ws + WS_SV), (bf16*)(ws + WS_GB), (bf16*)(ws + WS_U), ssq_h2, (const float*)(ws + WS_CSS)};
        pg8::gemm_phase<ep::EpiIn1, pg8::StaticOrder, false>(F.lds + RING_OFF, XB, (const bf16*)(ws + WS_W_IN1), 1024, S, E);
    }
    SEAM(7);
    if (IN(8)) { FRAME_TID();
        bf16* MIX1 = (bf16*)(ws + WS_MIX1);
        for (int i = 0; i < 4; ++i) {
            const int L = F.vcu * 4 + i, qb = L & 31, hq = (L >> 5) & 7, b = L >> 8; const size_t rb = (size_t)b * SEQ;
            att::Ptrs A; A.Qm = (const bf16*)(ws + WS_SQ) + rb * 512 + hq * 64; A.qp = 512; A.Qx = nullptr; A.qxp = 0; A.Km = (const bf16*)(ws + WS_SK) + rb * 128 + (hq >> 2) * 64; A.kp = 128; A.Kx = nullptr; A.kxp = 0;
            A.V = (const bf16*)(ws + WS_SV) + rb * 128 + (hq >> 2) * 64; A.vp = 128; A.O = MIX1 + rb * 1024 + hq * 64; A.op = 1024;
            att::attn_unit<4, 1, false>(A, qb * 256, ARG_IN(16)[hq] * LOG2E, (char*)lds + RING_OFF);
        }
        conv_phase(F, (const bf16*)(ws + WS_GB), (const bf16*)(ws + WS_U), ARG_IN(17), MIX1);
    }
    SEAM(8);
    if (IN(9)) { FRAME_TID();
        pg8::StaticOrder S; S.init(NTOK / 256, 4, F.G, bid);
        ep::EpiRes E{ARG_OUT(), ARG_OUT(), XB, nullptr};
        pg8::gemm_phase<ep::EpiRes, pg8::StaticOrder, false>(F.lds + RING_OFF, (const bf16*)(ws + WS_MIX1), (const bf16*)(ws + WS_W_OUT1), 1024, S, E);
    }
    SEAM(9);
#define LIST ((ListEnt*)(ws + WS_LIST))
    if (IN(10)) { FRAME_TID(); router_phase(F, ARG_OUT(), ARG_IN(19), ARG_IN(20), LIST, FCTL); }
    SEAM(10);
#pragma nounroll
    for (int rank = 0; rank < 2; ++rank) {
        const ListEnt* lst = LIST + (size_t)rank * 8 * NTOK;
        if (IN(11 + 2 * rank)) { FRAME_TID();
            MoeOrder S; S.init((LAS int*)(F.lds + LDSCTL_OFF), FCTL, rank, lst, 28, F.G, bid);
            ep::EpiMoe1 E{(bf16*)(ws + WS_HID1), lst};
            pg8::gemm_phase<ep::EpiMoe1, MoeOrder, true>(F.lds + RING_OFF, XB, (const bf16*)(ws + WS_WMOE_GU), 1024, S, E);
        }
        SEAM(11 + 2 * rank);
        if (IN(12 + 2 * rank)) { FRAME_TID();
            MoeOrder S; S.init((LAS int*)(F.lds + LDSCTL_OFF), FCTL, rank, lst, 4, F.G, bid);
            ep::EpiMoe2 E{ARG_OUT(), lst};
            pg8::gemm_phase<ep::EpiMoe2, MoeOrder, false>(F.lds + RING_OFF, (const bf16*)(ws + WS_HID1), (const bf16*)(ws + WS_WMOE_D), DFF, S, E);
        }
        SEAM(12 + 2 * rank);
    }
    if (IN(15)) { FRAME_TID();
        const int gw = F.vcu * NWAVES + F.wave, NGW = F.G * NWAVES; const float* gf = ARG_IN(24);
        for (int m = gw; m < NTOK; m += NGW) {
            GAS f32x4* xr = (GAS f32x4*)(ARG_OUT() + (size_t)m * DM) + F.lane;
            f32x4 v[4]; float s = 0.f;
#pragma unroll
            for (int j = 0; j < 4; ++j) { v[j] = xr[64 * j]; s += (v[j].x * v[j].x + v[j].y * v[j].y) + (v[j].z * v[j].z + v[j].w * v[j].w); }
            const float rstd = 1.f / sqrtf(wave_sum(s) * (1.f / DM) + RMS_EPS);
#pragma unroll
            for (int j = 0; j < 4; ++j) { const f32x4 g = *((const f32x4*)gf + F.lane + 64 * j); xr[64 * j] = v[j] * rstd * g; }
        }
    }
#undef IN
#undef SEAM
#undef ws
#undef dob
#undef ssq_q
#undef ssq_kv
#undef ssq_h1
#undef ssq_h2
#undef XB
#undef bid
#undef LIST
#undef FCTL
}
#ifndef DBG_STOP
#define DBG_STOP NPH
#endif
#ifndef DBG_STAGE
#define DBG_STAGE -1
#endif
extern "C" void kernel_launch(void* const* d_in, const int* in_sizes, int n_in, void* d_out, int out_size, void* d_ws, size_t ws_size, hipStream_t stream) {
    static int grid = 0;
    if (grid == 0) {
        if (n_in != 25 || in_sizes[0] != NTOK * DM || out_size != NTOK * DM || ws_size < WS_END) { fprintf(stderr, "kernel_launch: unexpected shapes / workspace (n_in %d, ws %zu)\n", n_in, ws_size); grid = -1; return; }
        int dev = 0, cus = 0, per_cu = 0;
        if (hipGetDevice(&dev) != hipSuccess || hipDeviceGetAttribute(&cus, hipDeviceAttributeMultiprocessorCount, dev) != hipSuccess) { grid = -1; return; }
        if (hipFuncSetAttribute((const void*)skel_fwd, hipFuncAttributeMaxDynamicSharedMemorySize, LDS_BYTES) != hipSuccess) { fprintf(stderr, "kernel_launch: hipFuncSetAttribute failed\n"); grid = -1; return; }
        if (hipOccupancyMaxActiveBlocksPerMultiprocessor(&per_cu, (const void*)skel_fwd, NWAVES * 64, LDS_BYTES) != hipSuccess || per_cu < 1) fprintf(stderr, "kernel_launch: occupancy query reports %d\n", per_cu);
        (void)hipGetLastError();
        grid = cus;
        if (grid != 256) { fprintf(stderr, "kernel_launch: built for 256 CUs, found %d\n", grid); grid = -1; return; }
    }
    if (grid < 0) return;
    if (hipMemsetAsync((char*)d_ws + WS_CTL, 0, CTL_ZERO_BYTES, stream) != hipSuccess) return;
    Args a{};
    for (int i = 0; i < 25; ++i) a.in[i] = (const float*)d_in[i];
    a.out = (float*)d_out; a.ws = (unsigned char*)d_ws; a.ph_lo = 0; a.ph_hi = DBG_STOP;
    hipLaunchKernelGGL(skel_fwd, dim3(grid), dim3(NWAVES * 64), LDS_BYTES, stream, a);
#if DBG_STAGE >= 1
    {   nv::Bufs B = nv::carve((unsigned char*)d_ws);
        for (int b = 0; b < 4; ++b) {
            float* hout = (float*)d_out + (size_t)b * nv::T * nv::DM;
#if DBG_STAGE == 1
            hipLaunchKernelGGL(nv::k_bf16_to_f32, dim3(nv::T * 1024 / 256), dim3(256), 0, stream, (const unsigned short*)((unsigned char*)d_ws + WS_MIX0) + (size_t)b * nv::T * 1024, B.mix, (size_t)nv::T * 1024);
#elif DBG_STAGE == 3
            hipLaunchKernelGGL(nv::k_bf16_to_f32, dim3(nv::T * 1024 / 256), dim3(256), 0, stream, (const unsigned short*)((unsigned char*)d_ws + WS_MIX1) + (size_t)b * nv::T * 1024, B.mix, (size_t)nv::T * 1024);
#endif
            nv::forward_batch(stream, d_in, b, hout, B, DBG_STAGE);
        } }
#endif
}
```

```cpp
#include <hip/hip_runtime.h>
#include <cstdio>
#include <cstdint>
#include <cmath>
namespace pg8 {
#define PG8_LAS __attribute__((address_space(3)))
typedef unsigned short bf16_t;
typedef short bf16x8 __attribute__((ext_vector_type(8)));
typedef float f32x4 __attribute__((ext_vector_type(4)));
typedef float f32x2 __attribute__((ext_vector_type(2)));
typedef unsigned u32x4 __attribute__((ext_vector_type(4)));
typedef unsigned u32x2 __attribute__((ext_vector_type(2)));
constexpr int BM = 256, BK = 64, HALF = 128, HTB = HALF * BK * 2  , STAGE_BYTES = 8 * HTB, NXCD = 8, WGM = 8;

__host__ __device__ __forceinline__ int lds_byte(int r, int c) { const int st = (r >> 4) * 2 + (c >> 5), rr = r & 15, cc = c & 31, ob = rr * 64 + cc * 2; return st * 1024 + (ob ^ (((ob >> 9) & 1) << 5)); }
__host__ __device__ __forceinline__ void stage_rc(int b, int& R, int& C) { const int st = b / 1024, sb = b % 1024, swz = sb ^ (((sb >> 9) & 1) << 5); R = (st >> 1) * 16 + swz / 64; C = (st & 1) * 32 + (swz % 64) / 2; }
__host__ __device__ __forceinline__ int perm32(int rho) { const int n = rho >> 4, i = rho & 15; return 8 * (i >> 2) + 4 * n + (i & 3); }

struct Unit { int pa, pb, pm, pn, e, nv, s0, kt0, ntu, slab; };

struct StaticOrder {
    int nM, nN, nwg, G, c;
    __device__ __forceinline__ void init(int nM_, int nN_, int G_, int c_) { nM = nM_; nN = nN_; nwg = nM * nN; G = G_; c = c_; }
    __device__ __forceinline__ bool tile(int i, int& pm, int& pn) const { return tile_lin((long)i * G + c, pm, pn); }
    __device__ __forceinline__ bool tile_lin(long L, int& pm, int& pn) const {
        if (L >= nwg) return false;
        int wgid = (int)L; { const int q = nwg / NXCD, r = nwg % NXCD, xcd = wgid % NXCD, off = wgid / NXCD; wgid = (xcd < r ? xcd * (q + 1) : r * (q + 1) + (xcd - r) * q) + off; }
        const int nig = WGM * nN, gid = wgid / nig, fm = gid * WGM, gsz = (nM - fm) < WGM ? (nM - fm) : WGM;
        pm = fm + ((wgid % nig) % gsz); pn = (wgid % nig) / gsz; return true;
    }
    __device__ __forceinline__ bool next(int i, Unit& u) const { int pm, pn; if (!tile(i, pm, pn)) return false; u.pa = pm; u.pb = pn; u.pm = pm; u.pn = pn; u.e = 0; u.nv = 256; u.s0 = 0; u.kt0 = 0; u.ntu = 0; u.slab = -1; return true; }
    __device__ __forceinline__ void fill(const Unit&, PG8_LAS unsigned*, int, int) const {}
};

__device__ __forceinline__ unsigned cvt_pk_bf16(float lo, float hi) { unsigned r; asm volatile("v_cvt_pk_bf16_f32 %0, %1, %2" : "=v"(r) : "v"(lo), "v"(hi)); return r; }
__device__ __forceinline__ u32x4 pack8(const f32x4 v0, const f32x4 v1) { u32x4 w; w.x = cvt_pk_bf16(v0[0], v0[1]); w.y = cvt_pk_bf16(v0[2], v0[3]); w.z = cvt_pk_bf16(v1[0], v1[1]); w.w = cvt_pk_bf16(v1[2], v1[3]); return w; }

template <class Epi, class Sched, bool GATHER, bool SPLITK = false, bool ATILED = false, int FP8 = 0>
__device__ __forceinline__ void gemm_phase(PG8_LAS unsigned char* lds, const int wv  , const bf16_t* Ag, const bf16_t* Btg, const int K, const Sched& S, const Epi& E, unsigned long long* diag = nullptr, int skew = 0) {
    unsigned long long dg_c0 = 0, dg_r0 = 0, dg_k = 0, dg_e = 0, dg_r = 0, dg_n = 0;
    int tid_; asm volatile("v_mbcnt_lo_u32_b32 %0, -1, 0\n\tv_mbcnt_hi_u32_b32 %0, -1, %0" : "=&v"(tid_)); tid_ += wv * 64;
    const int tid = tid_, wid = __builtin_amdgcn_readfirstlane(tid >> 6), lane = tid & 63, wr = wid >> 2, wc = wid & 3, fr = lane & 15, fq = lane >> 4;
    const int nt = K / BK;
    unsigned voffA[2], voffB[2];
#pragma unroll
    for (int i = 0; i < 2; ++i) { int R, C; stage_rc(tid * 16 + i * 8192, R, C); const int Rb = (R & ~31) + perm32(R & 31);
        voffA[i] = ATILED ? (unsigned)(R * BK + C) * 2u : (unsigned)(R * K + C) * 2u; voffB[i] = (unsigned)(Rb * K + C) * 2u; }
    const size_t kstep = (size_t)(BK * 2);
    const size_t hstep = (size_t)HALF * K * 2;
    const size_t tstep = 2 * hstep;
    const size_t kstepA = ATILED ? (size_t)BM * BK * 2 : kstep, hstepA = ATILED ? (size_t)HALF * BK * 2 : hstep;
    const unsigned ldsw = (unsigned)wid * 1024u;
    const int aoff = lds_byte(wr * 64 + fr, fq * 8), boff = lds_byte(wc * 32 + fr, fq * 8);
#define PG8_SA(b, h) (((b) * 2 + (h)) * HTB)
#define PG8_SB(b, h) ((4 + (b) * 2 + (h)) * HTB)
#define PG8_STAGE(bufoff, gbase, voff) do { _Pragma("unroll") for (int _i = 0; _i < 2; ++_i) \
        __builtin_amdgcn_global_load_lds((const unsigned*)((const char*)(gbase) + (voff)[_i]), (PG8_LAS unsigned*)(lds + (bufoff) + ldsw + _i * 8192), 16, 0, 0); } while (0)
#define PG8_STAGE_A(bufoff, aptr, h) do { if constexpr (GATHER) { PG8_STAGE(bufoff, aptr, vgC[h]); } else { PG8_STAGE(bufoff, (aptr) + (h) * hstepA, voffA); } } while (0)
#define PG8_LOOKUP(tabp, nvv) do { int t_ = tid; asm volatile("" : "+v"(t_));   \
        _Pragma("unroll") for (int _j = 0; _j < 2; ++_j) { int R_, C_; stage_rc(t_ * 16 + _j * 8192, R_, C_); _Pragma("unroll") for (int _h = 0; _h < 2; ++_h) { const int r_ = _h * 128 + R_; unsigned tk_ = (tabp)[r_]; tk_ = r_ < (nvv) ? tk_ : 0u; \
        vgC[_h][_j] = (tk_ * (unsigned)K + (unsigned)C_) * 2u; } } } while (0)
#define PG8_LD8(lo_, hi_) __builtin_shufflevector(lo_, hi_, 0, 1, 2, 3, 4, 5, 6, 7)
#define PG8_LDA(dst, b, h) do { if constexpr (FP8 == 2) { _Pragma("unroll") for (int m = 0; m < 4; ++m) dst##8[m] = PG8_LD8(*(const PG8_LAS i4_t*)(lds + PG8_SA(b, h) + aoff + m * 2048), *(const PG8_LAS i4_t*)(lds + PG8_SA(b, h) + aoff + m * 2048 + 1024)); } \
        else { _Pragma("unroll") for (int m = 0; m < 4; ++m) _Pragma("unroll") for (int k = 0; k < 2; ++k) dst[m][k] = *(const PG8_LAS bf16x8*)(lds + PG8_SA(b, h) + aoff + m * 2048 + k * 1024); } } while (0)
#define PG8_LDB(dst, b, h) do { if constexpr (FP8 == 2) { _Pragma("unroll") for (int n = 0; n < 2; ++n) dst##8[n] = PG8_LD8(*(const PG8_LAS i4_t*)(lds + PG8_SB(b, h) + boff + n * 2048), *(const PG8_LAS i4_t*)(lds + PG8_SB(b, h) + boff + n * 2048 + 1024)); } \
        else { _Pragma("unroll") for (int n = 0; n < 2; ++n) _Pragma("unroll") for (int k = 0; k < 2; ++k) dst[n][k] = *(const PG8_LAS bf16x8*)(lds + PG8_SB(b, h) + boff + n * 2048 + k * 1024); } } while (0)
#define PG8_MMA(ai, bj, At, Bt) do { __builtin_amdgcn_s_setprio(1); _Pragma("unroll") for (int m = 0; m < 4; ++m) _Pragma("unroll") for (int n = 0; n < 2; ++n) { \
        if constexpr (FP8 == 2) {   \
            acc[ai][bj][m][n] = __builtin_amdgcn_mfma_scale_f32_16x16x128_f8f6f4(Bt##8[n], At##8[m], acc[ai][bj][m][n], 0, 0, 0, 0x7F7F7F7F, 0, 0x7F7F7F7F); } \
        else if constexpr (FP8 == 1) { _Pragma("unroll") for (int k = 0; k < 2; ++k) { typedef long l2_t __attribute__((ext_vector_type(2))); const l2_t b_ = __builtin_bit_cast(l2_t, Bt[n][k]), a_ = __builtin_bit_cast(l2_t, At[m][k]); \
            acc[ai][bj][m][n] = __builtin_amdgcn_mfma_f32_16x16x32_fp8_fp8(b_[0], a_[0], acc[ai][bj][m][n], 0, 0, 0); acc[ai][bj][m][n] = __builtin_amdgcn_mfma_f32_16x16x32_fp8_fp8(b_[1], a_[1], acc[ai][bj][m][n], 0, 0, 0); } } \
        else { _Pragma("unroll") for (int k = 0; k < 2; ++k) acc[ai][bj][m][n] = __builtin_amdgcn_mfma_f32_16x16x32_bf16(Bt[n][k], At[m][k], acc[ai][bj][m][n], 0, 0, 0); } } __builtin_amdgcn_s_setprio(0); } while (0)
#define PG8_WAIT_V(n) asm volatile("s_waitcnt vmcnt(" #n ")" ::: "memory")
#define PG8_WAIT_L(n) asm volatile("s_waitcnt lgkmcnt(" #n ")" ::: "memory")
#define PG8_BAR __builtin_amdgcn_s_barrier()
#define PG8_SCHED __builtin_amdgcn_sched_barrier(0)
    Unit cur, nxt; int ui = 0;
    if (!S.next(0, cur)) return;
    if (skew > 0 && ((int)blockIdx.x & 1)) for (int q = 0; q < skew; ++q) __builtin_amdgcn_s_sleep(127);
    f32x4 acc[2][2][4][2];
#pragma unroll
    for (int a = 0; a < 2; ++a)
#pragma unroll
        for (int b = 0; b < 2; ++b)
#pragma unroll
            for (int m = 0; m < 4; ++m)
#pragma unroll
                for (int n = 0; n < 2; ++n) acc[a][b][m][n] = (f32x4){0.f, 0.f, 0.f, 0.f};
    typedef int i4_t __attribute__((ext_vector_type(4))); typedef int i8_t __attribute__((ext_vector_type(8)));
    bf16x8 At[FP8 == 2 ? 1 : 4][2], B0[FP8 == 2 ? 1 : 2][2], B1[FP8 == 2 ? 1 : 2][2];
    i8_t At8[FP8 == 2 ? 4 : 1], B08[FP8 == 2 ? 2 : 1], B18[FP8 == 2 ? 2 : 1];
    PG8_LAS unsigned* gtab = (PG8_LAS unsigned*)(lds + STAGE_BYTES + 1024);
    const PG8_LAS unsigned* tabC = gtab; const PG8_LAS unsigned* tabN = gtab + 256;
    unsigned vgC[2][2] = {{0u, 0u}, {0u, 0u}};
    if constexpr (GATHER) { S.fill(cur, gtab, wid, lane); PG8_WAIT_V(0); PG8_BAR; PG8_LOOKUP(tabC, cur.nv); }
    const char* cA = GATHER ? (const char*)Ag : (const char*)Ag + (size_t)cur.pa * tstep; const char* cB = (const char*)Btg + (size_t)cur.pb * tstep;
    if constexpr (SPLITK) { cA += (size_t)cur.kt0 * kstepA; cB += (size_t)cur.kt0 * kstep; }
    PG8_STAGE(PG8_SB(0, 0), cB, voffB); PG8_STAGE(PG8_SB(0, 1), cB + hstep, voffB); PG8_STAGE_A(PG8_SA(0, 0), cA, 0); PG8_STAGE_A(PG8_SA(0, 1), cA, 1);
    if (wr == 1) PG8_BAR;
    PG8_WAIT_V(2); PG8_BAR;
    PG8_STAGE(PG8_SB(1, 0), cB + kstep, voffB); PG8_STAGE_A(PG8_SA(1, 0), cA + kstepA, 0); PG8_STAGE(PG8_SB(1, 1), cB + hstep + kstep, voffB);
    PG8_WAIT_V(6); PG8_BAR;
    for (;;) {
        const bool has_next = S.next(ui + 1, nxt);
        typename Epi::Pre pre = E.prefetch(cur, wr, wc, fr, fq);
#ifdef PG8_DIAG
        if (diag) { dg_c0 = __builtin_readcyclecounter(); dg_r0 = __builtin_amdgcn_s_memrealtime(); }
#endif
        if constexpr (GATHER) { if (has_next) S.fill(nxt, (PG8_LAS unsigned*)tabN, wid, lane); }
        const char* nA = GATHER ? cA : (has_next ? (const char*)Ag + (size_t)nxt.pa * tstep : cA); const char* nB = has_next ? (const char*)Btg + (size_t)nxt.pb * tstep : cB;
        if constexpr (SPLITK) { if (has_next) { nA += (size_t)nxt.kt0 * kstepA; nB += (size_t)nxt.kt0 * kstep; } }
        const int ntc = SPLITK ? cur.ntu : nt;
#pragma nounroll
        for (int t = 0; t < ntc; t += 2) {
            const bool last = (t == ntc - 2);
            const char* a1 = cA + (size_t)(t + 1) * kstepA;
            const char* a2 = last ? nA : cA + (size_t)(t + 2) * kstepA; const char* b2 = last ? nB : cB + (size_t)(t + 2) * kstep;
            const char* a3 = a2 + kstepA; const char* b3 = b2 + kstep;
            if constexpr (FP8 == 2) {
                asm volatile("" : "+v"(voffB[0]), "+v"(voffB[1]));
                if constexpr (GATHER) asm volatile("" : "+v"(vgC[0][0]), "+v"(vgC[0][1]), "+v"(vgC[1][0]), "+v"(vgC[1][1])); else asm volatile("" : "+v"(voffA[0]), "+v"(voffA[1])); }
            if constexpr (FP8 == 2) { asm volatile("" : "+s"(a1), "+s"(a2), "+s"(a3), "+s"(b2), "+s"(b3)); }
            PG8_LDB(B0, 0, 0); PG8_LDB(B1, 0, 1); PG8_SCHED; PG8_LDA(At, 0, 0); PG8_STAGE_A(PG8_SA(1, 1), a1, 1);
            if constexpr (GATHER) { if (last && has_next) PG8_LOOKUP(tabN, nxt.nv); }
            PG8_WAIT_V(8); PG8_WAIT_L(0); PG8_BAR; PG8_MMA(0, 0, At, B0); PG8_MMA(0, 1, At, B1); PG8_BAR; PG8_SCHED;
            PG8_LDA(At, 0, 1); PG8_STAGE(PG8_SB(0, 0), b2, voffB); PG8_STAGE(PG8_SB(0, 1), b2 + hstep, voffB); PG8_STAGE_A(PG8_SA(0, 0), a2, 0);
            PG8_WAIT_V(8); PG8_WAIT_L(0); PG8_BAR; PG8_MMA(1, 0, At, B0); PG8_MMA(1, 1, At, B1); PG8_BAR; PG8_SCHED;
            PG8_LDB(B0, 1, 0); PG8_LDB(B1, 1, 1); PG8_SCHED; PG8_LDA(At, 1, 0); PG8_STAGE_A(PG8_SA(0, 1), a2, 1);
            PG8_WAIT_V(8); PG8_WAIT_L(0); PG8_BAR; PG8_MMA(0, 0, At, B0); PG8_MMA(0, 1, At, B1); PG8_BAR; PG8_SCHED;
            PG8_LDA(At, 1, 1); PG8_STAGE(PG8_SB(1, 0), b3, voffB); PG8_STAGE(PG8_SB(1, 1), b3 + hstep, voffB); PG8_STAGE_A(PG8_SA(1, 0), a3, 0);
            PG8_WAIT_V(8); PG8_WAIT_L(0); PG8_BAR; PG8_MMA(1, 0, At, B0); PG8_MMA(1, 1, At, B1); PG8_BAR; PG8_SCHED;
        }
        if (wr == 0) PG8_BAR;
#ifdef PG8_DIAG
        unsigned long long dg_c1 = 0; if (diag) dg_c1 = __builtin_readcyclecounter();
#endif
        { int l_; asm volatile("v_mbcnt_lo_u32_b32 %0, -1, 0\n\tv_mbcnt_hi_u32_b32 %0, -1, %0" : "=&v"(l_));
          E(acc, cur, wr, wc, l_ & 15, l_ >> 4, pre); }
#ifdef PG8_DIAG
        if (diag && ui > 0) { const unsigned long long c2 = __builtin_readcyclecounter(); dg_k += dg_c1 - dg_c0; dg_e += c2 - dg_c1; dg_r += __builtin_amdgcn_s_memrealtime() - dg_r0; dg_n += 1; }
#endif
        if (!has_next) break;
#pragma unroll
        for (int a = 0; a < 2; ++a)
#pragma unroll
            for (int b = 0; b < 2; ++b)
#pragma unroll
                for (int m = 0; m < 4; ++m)
#pragma unroll
                    for (int n = 0; n < 2; ++n) acc[a][b][m][n] = (f32x4){0.f, 0.f, 0.f, 0.f};
        cur = nxt; cA = nA; cB = nB; ++ui;
        if constexpr (GATHER) { const PG8_LAS unsigned* t_ = tabC; tabC = tabN; tabN = t_; }
        if (wr == 1) PG8_BAR;
    }
#ifdef PG8_DIAG
    if (diag && tid == 0) { diag[0] = dg_k; diag[1] = dg_e; diag[2] = dg_r; diag[3] = dg_n; }
#endif
    PG8_WAIT_V(0);
    PG8_BAR;
#undef PG8_SA
#undef PG8_SB
#undef PG8_STAGE
#undef PG8_STAGE_A
#undef PG8_LOOKUP
#undef PG8_LDA
#undef PG8_LD8
#undef PG8_LDB
#undef PG8_MMA
#undef PG8_WAIT_V
#undef PG8_WAIT_L
#undef PG8_BAR
#undef PG8_SCHED
}
}
namespace att {
using bf16x8 = __attribute__((ext_vector_type(8))) short;
using s16x4 = __attribute__((ext_vector_type(4))) short;
using f32x16 = __attribute__((ext_vector_type(16))) float;
using u32x4 = __attribute__((ext_vector_type(4))) unsigned;
typedef unsigned short bf16_t;
constexpr int NW = 8, QBLK = 32, QB = 256, KVBLK = 64;
constexpr int KSLOT = 12288, VSLOT = 8192, NSLOT = 4;
constexpr int LDS_K = 0, LDS_V = NSLOT * KSLOT, LDS_WS = LDS_V + NSLOT * VSLOT, LDS_OST = LDS_WS + NW * 256, LDS_BYTES = LDS_OST + NW * 4096;
__device__ __forceinline__ int crow(int r, int hi) { return (r & 3) + 8 * (r >> 2) + 4 * hi; }
__device__ __forceinline__ void glds16(const void* gsrc, unsigned lds_dst) { unsigned keep;
    asm volatile("s_mov_b32 %0, m0\n\ts_mov_b32 m0, %2\n\ts_nop 0\n\tglobal_load_lds_dwordx4 %1, off\n\ts_mov_b32 m0, %0" : "=&s"(keep) : "v"(gsrc), "s"(lds_dst) : "memory"); }
typedef float f32x2_t __attribute__((ext_vector_type(2))); typedef __bf16 bf16x2_t __attribute__((ext_vector_type(2)));
__device__ __forceinline__ unsigned cvtpk_s(float lo, float hi) { f32x2_t v = {lo, hi}; bf16x2_t b = __builtin_convertvector(v, bf16x2_t); return __builtin_bit_cast(unsigned, b); }
__device__ __forceinline__ unsigned short f2bf_s(float f) { return (unsigned short)(cvtpk_s(f, 0.f) & 0xffffu); }
#define ATT_WAIT_BAR() asm volatile("s_waitcnt vmcnt(0) lgkmcnt(0)\n\ts_barrier" ::: "memory")

struct Ptrs {
    const bf16_t* Qm; int qp; const bf16_t* Qx; int qxp; const bf16_t* Km; int kp; const bf16_t* Kx; int kxp; const bf16_t* V; int vp; bf16_t* O; int op; const float* aux;
};

template <int NKC>
__device__ __forceinline__ void qkt(f32x16& p0, f32x16& p1, const char* Kslot, const bf16x8* qr, const f32x16& negm, int r32, int hi) {
    typedef __attribute__((address_space(3))) const char* lptr;
    const lptr kb = (lptr)Kslot + hi * 1024 + r32 * 16;
    bf16x8 kf[2 * NKC];
#pragma unroll
    for (int d0 = 0; d0 < NKC; ++d0) { kf[2 * d0] = *(const __attribute__((address_space(3))) bf16x8*)(kb + d0 * 2048); kf[2 * d0 + 1] = *(const __attribute__((address_space(3))) bf16x8*)(kb + d0 * 2048 + 512); }
    __builtin_amdgcn_sched_barrier(0);
    __builtin_amdgcn_s_setprio(1);
#pragma unroll
    for (int d0 = 0; d0 < NKC; ++d0) {
        if (d0 == 0) { p0 = __builtin_amdgcn_mfma_f32_32x32x16_bf16(kf[0], qr[0], negm, 0, 0, 0); p1 = __builtin_amdgcn_mfma_f32_32x32x16_bf16(kf[1], qr[0], negm, 0, 0, 0); }
        else { p0 = __builtin_amdgcn_mfma_f32_32x32x16_bf16(kf[2 * d0], qr[d0], p0, 0, 0, 0); p1 = __builtin_amdgcn_mfma_f32_32x32x16_bf16(kf[2 * d0 + 1], qr[d0], p1, 0, 0, 0); }
    }
    __builtin_amdgcn_s_setprio(0);
}
__device__ __forceinline__ float max3f(float a, float b, float c) { float r; asm("v_max3_f32 %0, %1, %2, %3" : "=v"(r) : "v"(a), "v"(b), "v"(c)); return r; }
__device__ __forceinline__ float max2f(float a, float b) { float r; asm("v_max_f32_e32 %0, %1, %2" : "=v"(r) : "v"(a), "v"(b)); return r; }
__device__ __forceinline__ float rowmax(const f32x16& p0, const f32x16& p1) {
    float a = max3f(p0[0], p0[1], p1[0]), b = max3f(p0[2], p0[3], p1[1]); a = max3f(a, p1[2], p1[3]);
#pragma unroll
    for (int r = 4; r < 16; r += 4) { a = max3f(a, p0[r], p0[r + 1]); b = max3f(b, p0[r + 2], p0[r + 3]); a = max3f(a, p1[r], p1[r + 1]); b = max3f(b, p1[r + 2], p1[r + 3]); }
    const float m = max2f(a, b);
    auto rr = __builtin_amdgcn_permlane32_swap(__float_as_uint(m), __float_as_uint(m), false, false);
    return max2f(__uint_as_float(rr[0]), __uint_as_float(rr[1]));
}
struct VFrag { s16x4 lo[8], hi[8]; };
__device__ __forceinline__ void pv_issue(VFrag& f, int vb) {
#pragma unroll
    for (int d0 = 0; d0 < 2; ++d0)
#pragma unroll
        for (int ks = 0; ks < 4; ++ks) {
            asm volatile("ds_read_b64_tr_b16 %0,%1 offset:%c2" : "=&v"(f.lo[d0 * 4 + ks]) : "v"(vb), "i"(d0 * 4096 + ks * 1024) : "memory");
            asm volatile("ds_read_b64_tr_b16 %0,%1 offset:%c2" : "=&v"(f.hi[d0 * 4 + ks]) : "v"(vb), "i"(d0 * 4096 + ks * 1024 + 512) : "memory"); }
}
__device__ __forceinline__ void pv_mma(f32x16* o, VFrag& f, bf16x8 pa0, bf16x8 pa1, bf16x8 pa2, bf16x8 pa3) {
    asm volatile("s_waitcnt lgkmcnt(0)" : "+v"(f.lo[0]), "+v"(f.lo[1]), "+v"(f.lo[2]), "+v"(f.lo[3]), "+v"(f.lo[4]), "+v"(f.lo[5]), "+v"(f.lo[6]), "+v"(f.lo[7]),
                 "+v"(f.hi[0]), "+v"(f.hi[1]), "+v"(f.hi[2]), "+v"(f.hi[3]), "+v"(f.hi[4]), "+v"(f.hi[5]), "+v"(f.hi[6]), "+v"(f.hi[7]) :: "memory");
    __builtin_amdgcn_sched_barrier(0);
    __builtin_amdgcn_s_setprio(1);
#define ATT_PK(k) (bf16x8){f.lo[k][0], f.lo[k][1], f.lo[k][2], f.lo[k][3], f.hi[k][0], f.hi[k][1], f.hi[k][2], f.hi[k][3]}
    o[0] = __builtin_amdgcn_mfma_f32_32x32x16_bf16(pa0, ATT_PK(0), o[0], 0, 0, 0); o[1] = __builtin_amdgcn_mfma_f32_32x32x16_bf16(pa0, ATT_PK(4), o[1], 0, 0, 0);
    o[0] = __builtin_amdgcn_mfma_f32_32x32x16_bf16(pa1, ATT_PK(1), o[0], 0, 0, 0); o[1] = __builtin_amdgcn_mfma_f32_32x32x16_bf16(pa1, ATT_PK(5), o[1], 0, 0, 0);
    o[0] = __builtin_amdgcn_mfma_f32_32x32x16_bf16(pa2, ATT_PK(2), o[0], 0, 0, 0); o[1] = __builtin_amdgcn_mfma_f32_32x32x16_bf16(pa2, ATT_PK(6), o[1], 0, 0, 0);
    o[0] = __builtin_amdgcn_mfma_f32_32x32x16_bf16(pa3, ATT_PK(3), o[0], 0, 0, 0); o[1] = __builtin_amdgcn_mfma_f32_32x32x16_bf16(pa3, ATT_PK(7), o[1], 0, 0, 0);
    __builtin_amdgcn_s_setprio(0);
#undef ATT_PK
}

template <int NKC, int MODE, bool QONES>
__device__ __forceinline__ void attn_unit(const Ptrs& P, int q0, float sink_l2, char* shm, const int wv  ) {
    constexpr float THR = 8.f;
    int tid_; asm volatile("v_mbcnt_lo_u32_b32 %0, -1, 0\n\tv_mbcnt_hi_u32_b32 %0, -1, %0" : "=&v"(tid_)); tid_ += wv * 64;
    const int tid = tid_, lane = tid & 63, r32 = lane & 31, hi = lane >> 5; const int wid = __builtin_amdgcn_readfirstlane(tid >> 6), grp = wid >> 2;
    const unsigned lds0 = (unsigned)(uintptr_t)shm;
    float* wsf = (float*)(shm + LDS_WS) + wid * 64;
    const int qmin = q0 + wid * QBLK, qmax = qmin + QBLK - 1, qabs = qmin + r32;
    int t0 = 0; if (MODE == 1) { int lo = q0 - 127; if (lo < 0) lo = 0; t0 = lo / KVBLK; }
    if constexpr (QONES) {
        const int tq = q0 / KVBLK; const float qn = fmaxf(fmaxf(P.aux[384 + tq], P.aux[384 + tq + 1]), fmaxf(P.aux[384 + tq + 2], P.aux[384 + tq + 3])), bq0 = P.aux[256 + tq];
        const bool ok0 = (lane < tq) && (qn * P.aux[lane] + P.aux[128 + lane] - bq0 < -160.f), ok1 = (lane + 64 < tq) && (qn * P.aux[lane + 64] + P.aux[128 + lane + 64] - bq0 < -160.f);
        const unsigned long long m0 = __ballot(ok0), m1 = __ballot(ok1);
        int ts = (m0 == ~0ull) ? 64 + (int)__builtin_ctzll(~m1 | (1ull << 63)) : (int)__builtin_ctzll(~m0);
        if (m0 == ~0ull && m1 == ~0ull) ts = 127;
        t0 = __builtin_amdgcn_readfirstlane(ts);
    }
    const int t1 = (q0 + QB) / KVBLK - 1, NT = t1 - t0 + 1;
    const bf16_t* ksrc = P.Km + (long)lane * P.kp + wid * 8;
    const bf16_t* kxsrc = (NKC > 4) ? P.Kx + (long)lane * P.kxp + wid * 8 : nullptr;
    const bf16_t* vsrc = P.V + (long)(16 * (wid & 3) + (lane >> 2)) * P.vp + (wid >> 2) * 32 + (lane & 3) * 8;
    const unsigned kdst = lds0 + LDS_K + wid * 1024, kxdst = lds0 + LDS_K + (8 + wid) * 1024, vdst = lds0 + LDS_V + wid * 1024;
    const bool has_x = (NKC > 4) && (wid < 2 * (NKC - 4));
#define ATT_DMA(t, s) do { glds16(ksrc + (long)(t) * KVBLK * P.kp, (unsigned)__builtin_amdgcn_readfirstlane(kdst + (s) * KSLOT)); \
        if (has_x) glds16(kxsrc + (long)(t) * KVBLK * P.kxp, (unsigned)__builtin_amdgcn_readfirstlane(kxdst + (s) * KSLOT)); \
        glds16(vsrc + (long)(t) * KVBLK * P.vp, (unsigned)__builtin_amdgcn_readfirstlane(vdst + (s) * VSLOT)); } while (0)
    const int vb0 = (int)(lds0 + LDS_V) + ((lane >> 4) & 1) * 32 + (lane & 3) * 8 + (4 * hi + ((lane & 15) >> 2)) * 64;
    ATT_DMA(t0, 0); if (NT > 1) ATT_DMA(t0 + 1, 1);
    bf16x8 qr[NKC];
#pragma unroll
    for (int d0 = 0; d0 < 4; ++d0) qr[d0] = *reinterpret_cast<const bf16x8*>(P.Qm + (long)qabs * P.qp + d0 * 16 + hi * 8);
    if constexpr (NKC > 4) {
        if constexpr (QONES) { const short one = (short)0x3F80; qr[4] = hi == 0 ? (bf16x8){one, one, one, 0, 0, 0, 0, 0} : (bf16x8){0, 0, 0, 0, 0, 0, 0, 0}; }
        else {
#pragma unroll
            for (int d0 = 4; d0 < NKC; ++d0) qr[d0] = *reinterpret_cast<const bf16x8*>(P.Qx + (long)qabs * P.qxp + (d0 - 4) * 16 + hi * 8);
        }
    }
#pragma unroll
    for (int d0 = 0; d0 < NKC; ++d0) asm volatile("" :: "v"(qr[d0]));
    float mhat = (MODE == 1) ? sink_l2 : 0.f, l_reg = (MODE == 1 && hi == 0) ? 1.f : 0.f;
    if constexpr (QONES) { const bf16_t* kq = P.Kx + (long)qabs * P.kxp; const unsigned long long w = *(const unsigned long long*)kq;
        mhat = __uint_as_float((unsigned)(w & 0xffffu) << 16) + __uint_as_float((unsigned)((w >> 16) & 0xffffu) << 16) + __uint_as_float((unsigned)((w >> 32) & 0xffffu) << 16); }
    f32x16 o[2]; o[0] = f32x16{}; o[1] = f32x16{};
    f32x16 negm;
#pragma unroll
    for (int r = 0; r < 16; ++r) negm[r] = -mhat;
    asm volatile("" : "+v"(negm));
    bool first = (MODE == 0) && !QONES, act = false;
    f32x16 p0 = f32x16{}, p1 = f32x16{};
    int sdma = 2;
#define ATT_BAR(t) do { if ((t) >= t1) asm volatile("s_waitcnt vmcnt(0) lgkmcnt(0)\n\ts_barrier" ::: "memory"); \
        else if (has_x) asm volatile("s_waitcnt vmcnt(3) lgkmcnt(0)\n\ts_barrier" ::: "memory"); else asm volatile("s_waitcnt vmcnt(2) lgkmcnt(0)\n\ts_barrier" ::: "memory"); } while (0)
#define ATT_ISSUE(t) do { if ((t) + 2 <= t1) { ATT_DMA((t) + 2, sdma); sdma = (sdma == NSLOT - 1) ? 0 : sdma + 1; } } while (0)
#define ATT_H1(t, s) do { const int k0 = (t) * KVBLK; act = (k0 <= qmax) && (MODE == 0 || k0 + 63 >= qmin - 127); \
        if (!act) ATT_ISSUE(t); \
        if (act) { qkt<NKC>(p0, p1, shm + LDS_K + (s) * KSLOT, qr, negm, r32, hi); ATT_ISSUE(t); asm volatile("s_nop 15\n\ts_nop 7" : "+v"(p0), "+v"(p1));   \
            const bool needmask = (k0 + 63 > qmin) || (MODE == 1 && k0 < qmax - 127); \
            if (__builtin_expect(needmask, 0)) { _Pragma("unroll") for (int r = 0; r < 16; ++r) { const int kv = k0 + crow(r, hi); bool ok0 = kv <= qabs, ok1 = kv + 32 <= qabs; \
                if (MODE == 1) { ok0 = ok0 && (qabs - kv < 128); ok1 = ok1 && (qabs - kv - 32 < 128); } if (!ok0) p0[r] = -INFINITY; if (!ok1) p1[r] = -INFINITY; } } \
            const float rm = rowmax(p0, p1); \
            if (__builtin_expect(first || __any(rm > THR), 0)) {   \
                const float dl = first ? rm : fmaxf(rm, 0.f); const float f = first ? 0.f : __builtin_amdgcn_exp2f(-dl); first = false; mhat += dl; \
                _Pragma("unroll") for (int r = 0; r < 16; ++r) { p0[r] -= dl; p1[r] -= dl; negm[r] = -mhat; } \
                l_reg *= f; if (hi == 0) wsf[r32] = f; asm volatile("s_waitcnt lgkmcnt(0)" ::: "memory"); \
                _Pragma("unroll") for (int d_ = 0; d_ < 2; ++d_) _Pragma("unroll") for (int r = 0; r < 16; ++r) o[d_][r] *= wsf[crow(r, hi)]; } \
            if (QONES && __all(rm < -150.f)) act = false;   \
            if (act) { _Pragma("unroll") for (int r = 0; r < 16; ++r) p0[r] = __builtin_amdgcn_exp2f(p0[r]); }   } } while (0)
#define ATT_H2(s) do { if (act) { VFrag vf; pv_issue(vf, vb0 + (s) * VSLOT); float sacc = 0.f; _Pragma("unroll") for (int r = 0; r < 16; ++r) { p1[r] = __builtin_amdgcn_exp2f(p1[r]); sacc += p0[r] + p1[r]; } l_reg += sacc; \
        u32x4 pw0, pw1, pw2, pw3; \
        pw0 = (u32x4){cvtpk_s(p0[0], p0[1]), cvtpk_s(p0[2], p0[3]), cvtpk_s(p0[4], p0[5]), cvtpk_s(p0[6], p0[7])}; pw1 = (u32x4){cvtpk_s(p0[8], p0[9]), cvtpk_s(p0[10], p0[11]), cvtpk_s(p0[12], p0[13]), cvtpk_s(p0[14], p0[15])}; \
        pw2 = (u32x4){cvtpk_s(p1[0], p1[1]), cvtpk_s(p1[2], p1[3]), cvtpk_s(p1[4], p1[5]), cvtpk_s(p1[6], p1[7])}; pw3 = (u32x4){cvtpk_s(p1[8], p1[9]), cvtpk_s(p1[10], p1[11]), cvtpk_s(p1[12], p1[13]), cvtpk_s(p1[14], p1[15])}; \
        pv_mma(o, vf, __builtin_bit_cast(bf16x8, pw0), __builtin_bit_cast(bf16x8, pw1), __builtin_bit_cast(bf16x8, pw2), __builtin_bit_cast(bf16x8, pw3)); } } while (0)
#define ATT_NEXT(s) ((s) == NSLOT - 1 ? 0 : (s) + 1)
    if (grp == 0) {
        int s = 0;
        for (int t = t0; t <= t1; ++t) { ATT_BAR(t); ATT_H1(t, s); ATT_H2(s); s = ATT_NEXT(s); }
        ATT_BAR(t1 + 1);
    } else {
        int s = 0;
        ATT_BAR(t0); ATT_H1(t0, s);
        for (int t = t0 + 1; t <= t1; ++t) { ATT_BAR(t); ATT_H2(s); s = ATT_NEXT(s); ATT_H1(t, s); }
        ATT_BAR(t1 + 1); ATT_H2(s);
    }
#undef ATT_BAR
#undef ATT_ISSUE
#undef ATT_H1
#undef ATT_H2
#undef ATT_NEXT
    { auto rr = __builtin_amdgcn_permlane32_swap(__float_as_uint(l_reg), __float_as_uint(l_reg), false, false); l_reg = __uint_as_float(rr[0]) + __uint_as_float(rr[1]); }
    if (hi == 0) wsf[32 + r32] = l_reg;
    asm volatile("s_waitcnt lgkmcnt(0)" ::: "memory");
    float rli[16];
#pragma unroll
    for (int r = 0; r < 16; ++r) rli[r] = __builtin_amdgcn_rcpf(wsf[32 + crow(r, hi)]);
    bf16_t* Ow = P.O + (long)qmin * P.op;
    { bf16_t* stg = (bf16_t*)(shm + LDS_OST) + wid * 2048;
#pragma unroll
        for (int r = 0; r < 16; ++r) { const int orow = crow(r, hi);
#pragma unroll
            for (int d0 = 0; d0 < 2; ++d0) stg[orow * 64 + d0 * 32 + r32] = f2bf_s(o[d0][r] * rli[r]); }
        asm volatile("s_waitcnt lgkmcnt(0)" ::: "memory");
#pragma unroll
        for (int i = 0; i < 4; ++i) { const int row = i * 8 + (lane >> 3), ch = lane & 7; const u32x4 v = *(const u32x4*)(stg + row * 64 + ch * 8); *(u32x4*)(Ow + (long)row * P.op + ch * 8) = v; } }
    asm volatile("s_waitcnt lgkmcnt(0)\n\ts_barrier" ::: "memory");
#undef ATT_DMA
}
#undef ATT_WAIT_BAR
}
constexpr int NWAVES = 8;
constexpr int NTOK = 32768, SEQ = 8192, NB = 4, DM = 1024, DFF = 3584, NEXP = 8;
constexpr float RMS_EPS = 1e-6f;
constexpr float LOG2E = 1.4426950408889634f;
constexpr float W8_SCALE = 64.0f, W8_INV = 1.0f / 64.0f;
constexpr float C2_FOX = 0.125f * LOG2E, C2_MLA = 0.10206207261596577f * LOG2E, C2_SWA = 0.125f * LOG2E;
constexpr size_t MiB = 1u << 20;
#ifndef IN1_FP8
#define IN1_FP8 0
#endif
constexpr size_t WS_CTL = 0, CTL_ZERO_BYTES = 64 * 1024;
constexpr size_t WS_WMOE_GU = 2 * MiB;
constexpr size_t WS_XB8 = 60 * MiB;
constexpr size_t WS_WMOE_D = 114 * MiB;
constexpr size_t WS_XB = 170 * MiB;
constexpr size_t WS_BIG = 234 * MiB;
constexpr size_t WS_CQ = WS_BIG, WS_KPE = 258 * MiB, WS_MQ = 260 * MiB, WS_MKV = 308 * MiB, WS_MIX0 = 372 * MiB;
constexpr size_t WS_W_IN0 = 436 * MiB, WS_W_QUP = 441 * MiB, WS_W_KVUP = 442 * MiB, WS_W_OUT0 = 443 * MiB, WS_CSM = 445 * MiB, WS_FL = 449 * MiB, WS_FAUX = 450 * MiB;
constexpr size_t WS_HID0 = WS_BIG;
constexpr size_t WS_W_GU0 = 458 * MiB, WS_W_D0 = 472 * MiB, WS_W_IN1 = 479 * MiB, WS_W_OUT1 = 484 * MiB, WS_CSS = 486 * MiB;
constexpr size_t WS_SQ = WS_BIG, WS_SK = 266 * MiB, WS_SV = 274 * MiB, WS_GB = 282 * MiB, WS_U = 314 * MiB, WS_MIX1 = 346 * MiB;
constexpr size_t WS_LIST = WS_BIG, WS_HID1 = 242 * MiB;
constexpr int MOE_CAP = 270;
constexpr size_t WS_Y0 = 2 * MiB;
constexpr int SLAB_CAP = 512;
constexpr size_t WS_END = 527 * MiB;
constexpr size_t DO_FQ = 0, DO_FK = 32 * MiB, DO_FV = 64 * MiB, DO_KB = 96 * MiB, DO_CKV = 104 * MiB;
constexpr int CW_TMO = 0, CW_CODE = 1, CW_BAR = 4096, CW_CNT = 8192;
constexpr size_t WS_PQ = 494 * MiB, WS_PKV = 495 * MiB, WS_PH = 496 * MiB;
constexpr int RING_OFF = 0, RING_BYTES = 131072;
constexpr int LDSCTL_OFF = RING_BYTES, MISC_OFF = LDSCTL_OFF + 320;
constexpr int LDS_BYTES = 147456;

#define GAS __attribute__((address_space(1)))
#define LAS __attribute__((address_space(3)))
typedef unsigned short bf16;
typedef unsigned v4u __attribute__((ext_vector_type(4)));
typedef unsigned v2u __attribute__((ext_vector_type(2)));
typedef float f32x4 __attribute__((ext_vector_type(4)));
typedef float f32x2 __attribute__((ext_vector_type(2)));
typedef GAS unsigned gu32;
#define RLX_AGENT __ATOMIC_RELAXED, __HIP_MEMORY_SCOPE_AGENT
#define LDS_WAIT() asm volatile("s_waitcnt lgkmcnt(0)" ::: "memory")
#define VM_WAIT() asm volatile("s_waitcnt vmcnt(0)" ::: "memory")
__device__ __forceinline__ unsigned f2bf(float f) { unsigned u = __builtin_bit_cast(unsigned, f); return (u + 0x7fffu + ((u >> 16) & 1u)) >> 16; }
__device__ __forceinline__ float bf2f(unsigned b) { return __builtin_bit_cast(float, b << 16); }
__device__ __forceinline__ unsigned pk2(float lo, float hi) { return f2bf(lo) | (f2bf(hi) << 16); }

#define XB_TMO      128
#define XB_XCNT(j)  (256  + 64 * (j))
#define XB_XSUB(j)  (1280 + 64 * (j))
#define XB_XGEN(j)  (2304 + 64 * (j))
#define XB_TOP      3328
#define XB_TOPGEN   3392
#define XCD_BAR_WORDS 3456
#define XB_SPIN_CAP (1u << 18)
__device__ __forceinline__ unsigned xb_ld(unsigned* p)              { return __hip_atomic_load(p, __ATOMIC_RELAXED, __HIP_MEMORY_SCOPE_AGENT); }
__device__ __forceinline__ unsigned xb_add(unsigned* p, unsigned v) { return __hip_atomic_fetch_add(p, v, __ATOMIC_RELAXED, __HIP_MEMORY_SCOPE_AGENT); }
__device__ __forceinline__ unsigned xb_xcc_id() { return (unsigned)__builtin_amdgcn_s_getreg((3 << 11) | 20) & 0xFu; }
#define XB_SPIN(cond, bar) do { unsigned _sp = 0; while (cond) { __builtin_amdgcn_s_sleep(1); \
    if ((++_sp & 255u) == 0u) { if (xb_ld(&(bar)[XB_TMO])) break; if (_sp > XB_SPIN_CAP) { atomicAdd(&(bar)[XB_TMO], 1u); break; } } } } while (0)
__device__ __forceinline__ int lane_id() { int l; asm volatile("v_mbcnt_lo_u32_b32 %0, -1, 0\n\tv_mbcnt_hi_u32_b32 %0, -1, %0" : "=&v"(l)); return l; }
struct XcdBarrier { unsigned* bar; unsigned x; volatile LAS unsigned* st; };
__device__ __forceinline__ XcdBarrier xcd_barrier_post(unsigned* bar, volatile LAS unsigned* st, bool t0  ) {
    XcdBarrier b; b.bar = bar; b.x = xb_xcc_id(); b.st = st;
    if (t0) (void)xb_add(&bar[XB_XCNT(b.x)], 1u);
    return b;
}
__device__ __forceinline__ void xcd_barrier_complete(unsigned* bar, unsigned x, unsigned& nloc, unsigned& nx) {
    const unsigned G = gridDim.x * gridDim.y * gridDim.z;
    asm volatile("" : "+s"(x));
    unsigned sum, cnt, mine, sp = 0u;
    for (;;) {
        sum = 0u; cnt = 0u; mine = 0u;
#pragma unroll
        for (unsigned j = 0; j < 16; ++j) { const unsigned c = xb_ld(&bar[XB_XCNT(j)]); sum += c; cnt += (c > 0u) ? 1u : 0u; mine = (j == x) ? c : mine; }
        if (sum == G) break;
        __builtin_amdgcn_s_sleep(1);
        if ((++sp & 255u) == 0u) { if (xb_ld(&bar[XB_TMO])) break; if (sp > XB_SPIN_CAP) { atomicAdd(&bar[XB_TMO], 1u); break; } }
    }
    nloc = mine > 0u ? mine : 1u; nx = cnt > 0u ? cnt : 1u;
}
__device__ __forceinline__ void xcd_barrier(const XcdBarrier& b, bool t0  ) {
    asm volatile("s_waitcnt vmcnt(0)" ::: "memory");
    __syncthreads();
    if (t0) {
        unsigned* bar = b.bar;
        __builtin_amdgcn_s_waitcnt(0);
        unsigned nloc = b.st[0], nx = b.st[1];
        if (nloc == 0u) { xcd_barrier_complete(bar, b.x, nloc, nx); b.st[0] = nloc; b.st[1] = nx; }
        const unsigned old = xb_add(&bar[XB_XSUB(b.x)], 1u);
        const unsigned gen = old / nloc;
        if (old + 1u == (gen + 1u) * nloc) {
            __builtin_amdgcn_fence(__ATOMIC_RELEASE, "agent");
            asm volatile("s_waitcnt vmcnt(0)" ::: "memory");
            const unsigned og = xb_add(&bar[XB_TOP], 1u);
            const unsigned tg = og / nx;
            if (og + 1u == (tg + 1u) * nx) xb_add(&bar[XB_TOPGEN], 1u);
            else XB_SPIN(xb_ld(&bar[XB_TOPGEN]) == tg, bar);
            __builtin_amdgcn_fence(__ATOMIC_ACQUIRE, "agent");
            xb_add(&bar[XB_XGEN(b.x)], 1u);
            asm volatile("s_waitcnt vmcnt(0)" ::: "memory");
        } else {
            XB_SPIN(xb_ld(&bar[XB_XGEN(b.x)]) == gen, bar);
            __builtin_amdgcn_fence(__ATOMIC_ACQUIRE, "agent");
            asm volatile("s_waitcnt vmcnt(0)" ::: "memory");
        }
    }
    __syncthreads();
}

struct Frame {
    LAS unsigned char* lds;
    volatile LAS unsigned* MISC;
    int tid, lane, wave, vcu, G;
    const void* const* in_;
};
__device__ __forceinline__ float shx(float v, int o) { return __builtin_bit_cast(float, __builtin_amdgcn_ds_bpermute((lane_id() ^ o) << 2, __builtin_bit_cast(int, v))); }
__device__ __forceinline__ float shl(float v, int l) { return __builtin_bit_cast(float, __builtin_amdgcn_ds_bpermute(l << 2, __builtin_bit_cast(int, v))); }
__device__ __forceinline__ float wave_sum(float v) {
    const int l = lane_id();
#pragma unroll
    for (int o = 1; o < 64; o <<= 1) v += shl(v, l ^ o);
    return v;
}
struct ListEnt { int tok; float gw; float rs; int pad; };
namespace ep {
using pg8::f32x4; using pg8::u32x4; using pg8::u32x2; using pg8::Unit; using pg8::pack8; using pg8::bf16_t; using pg8::cvt_pk_bf16;
typedef const f32x4 (&Acc)[2][2][4][2];
struct NoPre {};
struct RowPre8 { float v[2][4]; };
struct RowPre { float v[2]; };
struct TokPre { int tok[2][4]; float gw[2][4]; };
__device__ __forceinline__ float sumsq8(const f32x4 a, const f32x4 b) { return ((a[0] * a[0] + a[1] * a[1]) + (a[2] * a[2] + a[3] * a[3])) + ((b[0] * b[0] + b[1] * b[1]) + (b[2] * b[2] + b[3] * b[3])); }
__device__ __forceinline__ float quad_sum(float s) { s += shx(s, 16); s += shx(s, 32); return s; }
__device__ __forceinline__ float rstd_of(float ssq, float inv_n) { return 1.0f / sqrtf(ssq * inv_n + RMS_EPS); }
template <int NS> __device__ __forceinline__ float ssq_sum(const float* part, size_t grow, int fq) {
    float s = 0.f;
    if (4 * fq < NS) { const f32x4 v = *(const f32x4*)(part + grow * NS + 4 * fq); s = (v[0] + v[1]) + (v[2] + v[3]); }
    return quad_sum(s);
}
__device__ __forceinline__ void rope_store(const f32x4 x1, const f32x4 x2, const float* cs, bf16_t* p1, bf16_t* p2) {
    const f32x4 a = *(const f32x4*)cs, b = *(const f32x4*)(cs + 4);
    const float c0 = a[0], s0 = a[1], c1 = a[2], s1 = a[3], c2 = b[0], s2 = b[1], c3 = b[2], s3 = b[3];
    u32x2 w1, w2;
    w1.x = cvt_pk_bf16(x1[0] * c0 - x2[0] * s0, x1[1] * c1 - x2[1] * s1); w1.y = cvt_pk_bf16(x1[2] * c2 - x2[2] * s2, x1[3] * c3 - x2[3] * s3);
    w2.x = cvt_pk_bf16(x2[0] * c0 + x1[0] * s0, x2[1] * c1 + x1[1] * s1); w2.y = cvt_pk_bf16(x2[2] * c2 + x1[2] * s2, x2[3] * c3 + x1[3] * s3);
    *(u32x2*)p1 = w1; *(u32x2*)p2 = w2;
}
__device__ __forceinline__ float rowpre_get(const RowPre& p, int g, int fr) { return shl(p.v[g & 1], fr + 16 * (g >> 1)); }
__device__ __forceinline__ float clamp8(float v) { return __builtin_amdgcn_fmed3f(v, -448.f, 448.f); }
__device__ __forceinline__ u32x2 pack8_fp8(const f32x4 v0, const f32x4 v1) { int a = 0, b = 0;
    a = __builtin_amdgcn_cvt_pk_fp8_f32(clamp8(v0[0]), clamp8(v0[1]), a, false); a = __builtin_amdgcn_cvt_pk_fp8_f32(clamp8(v0[2]), clamp8(v0[3]), a, true);
    b = __builtin_amdgcn_cvt_pk_fp8_f32(clamp8(v1[0]), clamp8(v1[1]), b, false); b = __builtin_amdgcn_cvt_pk_fp8_f32(clamp8(v1[2]), clamp8(v1[3]), b, true);
    u32x2 r; r.x = (unsigned)a; r.y = (unsigned)b; return r; }
#define EP_ROWS for (int ai = 0; ai < 2; ++ai) _Pragma("unroll") for (int m = 0; m < 4; ++m)
#define EP_GROW (u.pm * 256 + ai * 128 + wr * 64 + m * 16 + fr)

struct EpiIn0 {
    bf16_t *FQ, *CKV, *CQ, *KPE; float* FL; float *pq, *pkv; const float* CSM;
    typedef NoPre Pre;
    __device__ __forceinline__ Pre prefetch(const Unit& u, int wr, int wc, int fr, int fq) const { return Pre{}; }
    __device__ __forceinline__ void operator()(Acc acc, const Unit& u, int wr, int wc, int fr, int fq, const Pre& pre) const {
        const int cw = wc * 32 + fq * 8;
        if (u.pn < 6) {
#pragma unroll
            for (int bj = 0; bj < 2; ++bj) { const int cb = u.pn * 256 + bj * 128; bf16_t* dst = FQ + (size_t)(cb >> 9) * ((size_t)NTOK * 512); const int c = (cb + cw) & 511; const float sc = cb < 512 ? C2_FOX : 1.0f;
#pragma unroll
                EP_ROWS { const size_t grow = EP_GROW; *(u32x4*)(dst + grow * 512 + c) = pack8(acc[ai][bj][m][0] * sc, acc[ai][bj][m][1] * sc); } }
        } else if (u.pn == 6) {
#pragma unroll
            EP_ROWS { const size_t grow = EP_GROW; float s = 0.f;
#pragma unroll
                for (int bj = 0; bj < 2; ++bj) { const f32x4 v0 = acc[ai][bj][m][0], v1 = acc[ai][bj][m][1]; *(u32x4*)(CKV + grow * 256 + bj * 128 + cw) = pack8(v0, v1); s += sumsq8(v0, v1); }
                s = quad_sum(s); if (fq == 0) pkv[grow * 4 + wc] = s; }
        } else if (u.pn == 7) {
#pragma unroll
            EP_ROWS { const size_t grow = EP_GROW; float s = 0.f;
#pragma unroll
                for (int bj = 0; bj < 2; ++bj) { const f32x4 v0 = acc[ai][bj][m][0], v1 = acc[ai][bj][m][1]; *(u32x4*)(CQ + grow * 384 + bj * 128 + cw) = pack8(v0, v1); s += sumsq8(v0, v1); }
                s = quad_sum(s); if (fq == 0) pq[grow * 8 + wc] = s; }
        } else {
#pragma unroll
            EP_ROWS { const size_t grow = EP_GROW; const f32x4 v0 = acc[ai][0][m][0], v1 = acc[ai][0][m][1]; *(u32x4*)(CQ + grow * 384 + 256 + cw) = pack8(v0, v1);
                const float s = quad_sum(sumsq8(v0, v1)); if (fq == 0) pq[grow * 8 + 4 + wc] = s; }
            if (wc == 0) {
#pragma unroll
                EP_ROWS { const size_t grow = EP_GROW; rope_store(acc[ai][1][m][0], acc[ai][1][m][1], CSM + (grow * 16 + 4 * fq) * 2, KPE + grow * 32 + 4 * fq, KPE + grow * 32 + 16 + 4 * fq); if (m & 1) asm volatile("" ::: "memory"); }
            } else if (wc == 1 && fq == 0) {
#pragma unroll
                EP_ROWS { const size_t grow = EP_GROW; *(f32x4*)(FL + grow * 8) = acc[ai][1][m][0]; *(f32x4*)(FL + grow * 8 + 4) = acc[ai][1][m][1]; }
            }
        }
    }
};
struct EpiQup {
    bf16_t* MQ; const float* pq; const float* CSM;
    typedef NoPre Pre;
    __device__ __forceinline__ Pre prefetch(const Unit& u, int wr, int wc, int fr, int fq) const { return Pre{}; }
    __device__ __forceinline__ void operator()(Acc acc, const Unit& u, int wr, int wc, int fr, int fq, const Pre& pre) const {
        float rqv[2][4];
#pragma unroll
        EP_ROWS { rqv[ai][m] = ssq_sum<8>(pq, EP_GROW, fq); }
        asm volatile("" ::: "memory");
#pragma unroll
        EP_ROWS { const size_t grow = EP_GROW; const float rq = rstd_of(rqv[ai][m], 1.0f / 384.0f) * C2_MLA;
#pragma unroll
            for (int bj = 0; bj < 2; ++bj) { const int col8 = u.pn * 256 + bj * 128 + wc * 32 + fq * 8; const f32x4 v0 = acc[ai][bj][m][0] * rq, v1 = acc[ai][bj][m][1] * rq;
                if (u.pn < 2) { const int h = col8 >> 6, d = col8 & 63; *(u32x4*)(MQ + grow * 768 + h * 96 + d) = pack8(v0, v1); }
                else { const int j = col8 - 512, h = j >> 5, g = (j & 31) >> 3; rope_store(v0, v1, CSM + (grow * 16 + 4 * g) * 2, MQ + grow * 768 + h * 96 + 64 + 4 * g, MQ + grow * 768 + h * 96 + 80 + 4 * g); } }
            asm volatile("" ::: "memory"); }
    }
};
struct EpiKVup {
    bf16_t* MKV; const float* pkv;
    typedef NoPre Pre;
    __device__ __forceinline__ Pre prefetch(const Unit& u, int wr, int wc, int fr, int fq) const { return Pre{}; }
    __device__ __forceinline__ void operator()(Acc acc, const Unit& u, int wr, int wc, int fr, int fq, const Pre& pre) const {
        float rkv[2][4];
#pragma unroll
        EP_ROWS { rkv[ai][m] = ssq_sum<4>(pkv, EP_GROW, fq); }
        asm volatile("" ::: "memory");
#pragma unroll
        EP_ROWS { const size_t grow = EP_GROW; const float rk = rstd_of(rkv[ai][m], 1.0f / 256.0f);
#pragma unroll
            for (int bj = 0; bj < 2; ++bj) { const int col8 = u.pn * 256 + bj * 128 + wc * 32 + fq * 8; *(u32x4*)(MKV + grow * 1024 + col8) = pack8(acc[ai][bj][m][0] * rk, acc[ai][bj][m][1] * rk); } }
    }
};
template <bool BASE_BF16, bool WRITE_F32>
struct EpiRes {
    const float* base32; const bf16_t* base16; float* out; bf16_t* xb; float* part; unsigned char* xb8;
    typedef NoPre Pre;
    __device__ __forceinline__ Pre prefetch(const Unit& u, int wr, int wc, int fr, int fq) const { return Pre{}; }
    __device__ __forceinline__ void operator()(Acc acc, const Unit& u, int wr, int wc, int fr, int fq, const Pre& pre) const {
        f32x4 bb[2][2][2];
        u32x4 bh[2][2];
        const size_t col = (size_t)u.pn * 256 + wc * 32 + fq * 8;
#define EPR_LOAD(buf, g) do { const size_t grow_ = (size_t)u.pm * 256 + ((g) >> 2) * 128 + wr * 64 + ((g) & 3) * 16 + fr; _Pragma("unroll") for (int bj = 0; bj < 2; ++bj) { \
            if constexpr (BASE_BF16) { bh[buf][bj] = *(const u32x4*)(base16 + grow_ * 1024 + col + bj * 128); } \
            else { const float* p_ = base32 + grow_ * 1024 + col + bj * 128; bb[buf][bj][0] = *(const f32x4*)p_; bb[buf][bj][1] = *(const f32x4*)(p_ + 4); } } } while (0)
        EPR_LOAD(0, 0);
#pragma unroll
        for (int g = 0; g < 8; ++g) {
            const int ai = g >> 2, m = g & 3, cb = g & 1;
            if (g < 7) { if (cb == 0) EPR_LOAD(1, g + 1); else EPR_LOAD(0, g + 1); }
            const size_t grow = (size_t)u.pm * 256 + ai * 128 + wr * 64 + m * 16 + fr; float s = 0.f;
#pragma unroll
            for (int bj = 0; bj < 2; ++bj) { const size_t off = grow * 1024 + col + bj * 128; f32x4 b0, b1;
                if constexpr (BASE_BF16) { const u32x4 w = bh[cb][bj];
                    b0 = (f32x4){__uint_as_float(w.x << 16), __uint_as_float(w.x & 0xffff0000u), __uint_as_float(w.y << 16), __uint_as_float(w.y & 0xffff0000u)};
                    b1 = (f32x4){__uint_as_float(w.z << 16), __uint_as_float(w.z & 0xffff0000u), __uint_as_float(w.w << 16), __uint_as_float(w.w & 0xffff0000u)}; }
                else { b0 = bb[cb][bj][0]; b1 = bb[cb][bj][1]; }
                const f32x4 h0 = b0 + acc[ai][bj][m][0], h1 = b1 + acc[ai][bj][m][1];
                if constexpr (WRITE_F32) { *(f32x4*)(out + off) = h0; *(f32x4*)(out + off + 4) = h1; }
                *(u32x4*)(xb + off) = pack8(h0, h1); if (xb8) *(u32x2*)(xb8 + off) = pack8_fp8(h0, h1); s += sumsq8(h0, h1); }
            if (part) { s = quad_sum(s); if (fq == 0) part[grow * 16 + u.pn * 4 + wc] = s; }
            asm volatile("" ::: "memory");
        }
#undef EPR_LOAD
    }
};
__device__ __forceinline__ f32x4 silu_mul(const f32x4 a, const f32x4 b, const float k1, const float k2) {
    const f32x4 t = a * k1; f32x4 e;
#pragma unroll
    for (int i = 0; i < 4; ++i) e[i] = __builtin_amdgcn_exp2f(t[i]);
    float one = 1.0f; asm("" : "+v"(one));
    const f32x4 d = e + one; f32x4 r;
#pragma unroll
    for (int i = 0; i < 4; ++i) r[i] = __builtin_amdgcn_rcpf(d[i]);
    return (a * b) * (r * k2);
}
struct EpiGU {
    bf16_t* HID; const float* part; int probe_mode;
    typedef RowPre Pre;
    __device__ __forceinline__ Pre prefetch(const Unit& u, int wr, int wc, int fr, int fq) const { Pre p;
#pragma unroll
        for (int j = 0; j < 2; ++j) { const int g = 2 * fq + j, lrow = (g >> 2) * 128 + wr * 64 + (g & 3) * 16 + fr; p.v[j] = part[(size_t)u.pm * 256 + lrow]; }
        return p; }
    __device__ __forceinline__ void operator()(Acc acc, const Unit& u, int wr, int wc, int fr, int fq, const Pre& pre) const {
#pragma unroll
        EP_ROWS { const int lrow = ai * 128 + wr * 64 + m * 16 + fr; const float rs = rowpre_get(pre, 4 * ai + m, fr), k1 = -rs * LOG2E, k2 = rs * rs;
            const f32x4 h0 = silu_mul(acc[ai][0][m][0], acc[ai][1][m][0], k1, k2), h1 = silu_mul(acc[ai][0][m][1], acc[ai][1][m][1], k1, k2);
            *(u32x4*)(HID + (((size_t)u.pm * (DFF / 64) + 2 * u.pn + (wc >> 1)) * 256 + lrow) * 64 + (wc & 1) * 32 + fq * 8) = pack8(h0, h1); }
    }
};
struct EpiIn1 {
    bf16_t *SQ, *SK, *SV, *GB, *U; const float* part; const float* CSS;
    typedef NoPre Pre;
    __device__ __forceinline__ Pre prefetch(const Unit& u, int wr, int wc, int fr, int fq) const { return Pre{}; }
    __device__ __forceinline__ void operator()(Acc acc, const Unit& u, int wr, int wc, int fr, int fq, const Pre& pre) const {
        float rsv[2][4];
#pragma unroll
        EP_ROWS { rsv[ai][m] = ssq_sum<16>(part, EP_GROW, fq); }
        asm volatile("" ::: "memory");
#pragma unroll
        EP_ROWS { const size_t grow = EP_GROW; const float rs = rstd_of(rsv[ai][m], 1.0f / 1024.0f) * (IN1_FP8 ? W8_INV : 1.0f);
            if (u.pn < 2) {
#pragma unroll
                for (int bj = 0; bj < 2; ++bj) { const int col8 = u.pn * 256 + bj * 128 + wc * 32 + fq * 8, hd = col8 >> 6, g = (col8 & 63) >> 3; const float sc = rs * C2_SWA;
                    rope_store(acc[ai][bj][m][0] * sc, acc[ai][bj][m][1] * sc, CSS + (grow * 32 + 4 * g) * 2, SQ + grow * 512 + hd * 64 + 4 * g, SQ + grow * 512 + hd * 64 + 32 + 4 * g); }
            } else if (u.pn == 2) {
                { const int col8 = wc * 32 + fq * 8, hd = col8 >> 6, g = (col8 & 63) >> 3;
                  rope_store(acc[ai][0][m][0] * rs, acc[ai][0][m][1] * rs, CSS + (grow * 32 + 4 * g) * 2, SK + grow * 128 + hd * 64 + 4 * g, SK + grow * 128 + hd * 64 + 32 + 4 * g); }
                *(u32x4*)(SV + grow * 128 + wc * 32 + fq * 8) = pack8(acc[ai][1][m][0] * rs, acc[ai][1][m][1] * rs);
            } else if (u.pn < 5) {
#pragma unroll
                for (int bj = 0; bj < 2; ++bj) *(u32x4*)(GB + grow * 512 + (u.pn - 3) * 256 + bj * 128 + wc * 32 + fq * 8) = pack8(acc[ai][bj][m][0] * rs, acc[ai][bj][m][1] * rs);
            } else {
                const float r2 = rs * rs;
                *(u32x4*)(U + grow * 512 + (u.pn - 5) * 128 + wc * 32 + fq * 8) = pack8(acc[ai][0][m][0] * acc[ai][1][m][0] * r2, acc[ai][0][m][1] * acc[ai][1][m][1] * r2);
            }
            asm volatile("" ::: "memory"); }
    }
};
struct EpiMoe1 {
    bf16_t* HID1; const ListEnt* list;
    typedef RowPre Pre;
    __device__ __forceinline__ Pre prefetch(const Unit& u, int wr, int wc, int fr, int fq) const { Pre p;
#pragma unroll
        for (int j = 0; j < 2; ++j) { const int g = 2 * fq + j, lrow = (g >> 2) * 128 + wr * 64 + (g & 3) * 16 + fr; p.v[j] = 0.f; if (lrow < u.nv) p.v[j] = list[(size_t)u.e * NTOK + u.s0 + lrow].rs; }
        return p; }
    __device__ __forceinline__ void operator()(Acc acc, const Unit& u, int wr, int wc, int fr, int fq, const Pre& pre) const {
#pragma unroll
        EP_ROWS { const int lrow = ai * 128 + wr * 64 + m * 16 + fr; const float rs = rowpre_get(pre, 4 * ai + m, fr) * W8_INV;
            const float k1 = -rs * LOG2E, k2 = rs * rs;
            const f32x4 h0 = silu_mul(acc[ai][0][m][0], acc[ai][1][m][0], k1, k2), h1 = silu_mul(acc[ai][0][m][1], acc[ai][1][m][1], k1, k2);
            *(u32x2*)((unsigned char*)HID1 + (((size_t)u.pm * (DFF / 128) + u.pn) * 256 + lrow) * 128 + wc * 32 + fq * 8) = pack8_fp8(h0, h1); }
    }
};
struct EpiMoe2 {
    bf16_t* xb; bf16_t* y0; const ListEnt* list; float* slabs;
    typedef NoPre Pre;
    __device__ __forceinline__ Pre prefetch(const Unit& u, int wr, int wc, int fr, int fq) const { return Pre{}; }
    __device__ __forceinline__ void operator()(Acc acc, const Unit& u, int wr, int wc, int fr, int fq, const Pre& pre) const {
        if (u.slab >= 0) { float* sb = slabs + (size_t)u.slab * 65536;
#pragma unroll
            EP_ROWS { const int lrow = ai * 128 + wr * 64 + m * 16 + fr;
#pragma unroll
                for (int bj = 0; bj < 2; ++bj) { float* p = sb + lrow * 256 + bj * 128 + wc * 32 + fq * 8; *(f32x4*)p = acc[ai][bj][m][0]; *(f32x4*)(p + 4) = acc[ai][bj][m][1]; } }
            return; }
        if (u.e < 8) {
#pragma unroll
            EP_ROWS { const int lrow = ai * 128 + wr * 64 + m * 16 + fr;
                if (lrow < u.nv) { const ListEnt en = list[(size_t)u.e * NTOK + u.s0 + lrow]; const float gs = en.gw * W8_INV;
#pragma unroll
                    for (int bj = 0; bj < 2; ++bj) { const size_t off = (size_t)en.tok * 1024 + u.pn * 256 + bj * 128 + wc * 32 + fq * 8; *(u32x4*)(y0 + off) = pack8(acc[ai][bj][m][0] * gs, acc[ai][bj][m][1] * gs); } }
                if (m & 1) asm volatile("" ::: "memory"); }
            return; }
#pragma unroll
        EP_ROWS { const int lrow = ai * 128 + wr * 64 + m * 16 + fr;
            if (lrow < u.nv) { const ListEnt en = list[(size_t)u.e * NTOK + u.s0 + lrow];
#pragma unroll
                for (int bj = 0; bj < 2; ++bj) { const size_t off = (size_t)en.tok * 1024 + u.pn * 256 + bj * 128 + wc * 32 + fq * 8; const u32x4 w = *(const u32x4*)(xb + off);
                    const f32x4 b0 = (f32x4){__uint_as_float(w.x << 16), __uint_as_float(w.x & 0xffff0000u), __uint_as_float(w.y << 16), __uint_as_float(w.y & 0xffff0000u)};
                    const f32x4 b1 = (f32x4){__uint_as_float(w.z << 16), __uint_as_float(w.z & 0xffff0000u), __uint_as_float(w.w << 16), __uint_as_float(w.w & 0xffff0000u)};
                    const float gs = en.gw * W8_INV; *(u32x4*)(xb + off) = pack8(b0 + acc[ai][bj][m][0] * gs, b1 + acc[ai][bj][m][1] * gs); } }
            if (m & 1) asm volatile("" ::: "memory"); }
    }
};
#undef EP_ROWS
#undef EP_GROW
}
__device__ const float INV_FREQ64[32] = {1.000000000e+00f, 7.498942614e-01f, 5.623413324e-01f, 4.216965139e-01f, 3.162277639e-01f, 2.371373773e-01f, 1.778279394e-01f, 1.333521307e-01f,
    1.000000015e-01f, 7.498941571e-02f, 5.623413250e-02f, 4.216965288e-02f, 3.162277490e-02f, 2.371373773e-02f, 1.778279431e-02f, 1.333521493e-02f, 9.999999776e-03f, 7.498941850e-03f,
    5.623413250e-03f, 4.216964822e-03f, 3.162277630e-03f, 2.371373586e-03f, 1.778279431e-03f, 1.333521446e-03f, 1.000000047e-03f, 7.498942432e-04f, 5.623413017e-04f, 4.216965172e-04f,
    3.162277571e-04f, 2.371373703e-04f, 1.778279402e-04f, 1.333521504e-04f};

struct MapId { const float* W; int ldw_; __device__ __forceinline__ const float* col(int n) const { return W + n; } __device__ __forceinline__ int ldw() const { return ldw_; } };
struct MapIn0 { const float* W; __device__ __forceinline__ int ldw() const { return 2216; }
    __device__ __forceinline__ const float* col(int n) const { int s;
        if (n < 1536) s = n; else if (n < 1792) s = 1928 + (n - 1536); else if (n < 2176) s = 1544 + (n - 1792);
        else if (n < 2208) { const int j = n - 2176, g = j >> 3, e = j & 7; s = 2184 + (e < 4 ? 4 * g + e : 16 + 4 * g + (e - 4)); }
        else if (n < 2216) s = 1536 + (n - 2208); else return nullptr;
        return W + s; } };
struct MapQup { const float* W; __device__ __forceinline__ int ldw() const { return 768; }
    __device__ __forceinline__ const float* col(int n) const { int s;
        if (n < 512) { s = (n >> 6) * 96 + (n & 63); } else { const int j = n - 512, h = j >> 5, g = (j & 31) >> 3, e = j & 7; s = h * 96 + 64 + (e < 4 ? 4 * g + e : 16 + 4 * g + (e - 4)); }
        return W + s; } };
struct MapGU { const float* Wg; const float* Wu; __device__ __forceinline__ int ldw() const { return DFF; }
    __device__ __forceinline__ const float* col(int n) const { const int pn = n >> 8, j = n & 255; return j < 128 ? Wg + 128 * pn + j : Wu + 128 * pn + (j - 128); } };
struct MapIn1 { const float* W; __device__ __forceinline__ int ldw() const { return 2304; }
    __device__ __forceinline__ const float* col(int n) const { int s;
        if (n < 640) { const int hd = n >> 6, j = n & 63, g = j >> 3, e = j & 7; s = hd * 64 + (e < 4 ? 4 * g + e : 32 + 4 * g + (e - 4)); }
        else if (n < 1280) s = n; else { const int u = (n - 1280) >> 8, j = (n - 1280) & 255; s = j < 128 ? 1280 + 128 * u + j : 1792 + 128 * u + (j - 128); }
        return W + s; } };
struct TrDesc { const float* cp; const float* gain; bf16* WT; int ldw, K, k0, n0, f8; };
template <class Map>
__device__ __forceinline__ void tr_desc(TrDesc& d, const Map& M, const float* gain, int K, int ND, bf16* WT, int item, int lane) {
    const int nblk = ND / 32, kb = item / nblk, nb = item % nblk; d.k0 = 64 * kb; d.n0 = 32 * nb; d.cp = M.col(d.n0 + (lane & 7) * 4); d.ldw = M.ldw(); d.gain = gain; d.K = K; d.WT = WT; d.f8 = 0;
}
__device__ __forceinline__ void tr_load(const TrDesc& d, f32x4 (&v)[8], int lane) {
    const int kr = lane >> 3;
#pragma unroll
    for (int i = 0; i < 8; ++i) { v[i] = (f32x4){0.f, 0.f, 0.f, 0.f}; if (d.cp) v[i] = __builtin_nontemporal_load((const f32x4*)(d.cp + (size_t)(d.k0 + kr + 8 * i) * d.ldw)); }
}
__device__ __forceinline__ void tr_finish(const TrDesc& d, const f32x4 (&v)[8], LAS float* scr, int lane) {
    const int nq = (lane & 7) * 4, kr = lane >> 3;
#pragma unroll
    for (int i = 0; i < 8; ++i) { const int kk = kr + 8 * i; const float gk = d.gain ? d.gain[d.k0 + kk] : 1.0f; LAS float* p = scr + kk * 33 + nq; p[0] = v[i][0] * gk; p[1] = v[i][1] * gk; p[2] = v[i][2] * gk; p[3] = v[i][3] * gk; }
    LDS_WAIT(); asm volatile("" ::: "memory");
    if (d.f8) {
        const int c4 = lane & 3;
#pragma unroll
        for (int j = 0; j < 2; ++j) { const int n = (lane >> 2) + 16 * j; const LAS float* s = scr + (16 * c4) * 33 + n; v4u o;
#pragma unroll
            for (int w = 0; w < 4; ++w) { int pk = 0;
                pk = __builtin_amdgcn_cvt_pk_fp8_f32(__builtin_amdgcn_fmed3f(s[(4 * w + 0) * 33] * W8_SCALE, -448.f, 448.f), __builtin_amdgcn_fmed3f(s[(4 * w + 1) * 33] * W8_SCALE, -448.f, 448.f), pk, false);
                pk = __builtin_amdgcn_cvt_pk_fp8_f32(__builtin_amdgcn_fmed3f(s[(4 * w + 2) * 33] * W8_SCALE, -448.f, 448.f), __builtin_amdgcn_fmed3f(s[(4 * w + 3) * 33] * W8_SCALE, -448.f, 448.f), pk, true);
                o[w] = (unsigned)pk; }
            *(GAS v4u*)((unsigned char*)d.WT + (size_t)(d.n0 + n) * d.K + d.k0 + 16 * c4) = o; }
        LDS_WAIT(); asm volatile("" ::: "memory"); return;
    }
    const int c = lane & 7;
#pragma unroll
    for (int j = 0; j < 4; ++j) { const int n = (lane >> 3) + 8 * j; const LAS float* s = scr + (8 * c) * 33 + n;
        v4u o; o.x = pk2(s[0 * 33], s[1 * 33]); o.y = pk2(s[2 * 33], s[3 * 33]); o.z = pk2(s[4 * 33], s[5 * 33]); o.w = pk2(s[6 * 33], s[7 * 33]);
        *(GAS v4u*)(d.WT + (size_t)(d.n0 + n) * d.K + d.k0 + 8 * c) = o; }
    LDS_WAIT(); asm volatile("" ::: "memory");
}
__device__ __forceinline__ void rstd_rows(const Frame& F, const float* part, float* rs, int pm) {
    const size_t row = (size_t)pm * 256 + (F.tid >> 1); const float* p = part + row * 16 + (F.tid & 1) * 8;
    const f32x4 a = *(const f32x4*)p, b = *(const f32x4*)(p + 4);
    float s = ((a[0] + a[1]) + (a[2] + a[3])) + ((b[0] + b[1]) + (b[2] + b[3]));
    s += shx(s, 1);
    if ((F.tid & 1) == 0) rs[row] = 1.0f / sqrtf(s * (1.0f / DM) + RMS_EPS);
}
struct Args { const float* in[25]; float* out; unsigned char* ws; int ph_lo, ph_hi; };
#define P0_IN(i) (*(const float* const __attribute__((address_space(4)))*)((__attribute__((address_space(4))) const unsigned char*)__builtin_amdgcn_kernarg_segment_ptr() + 8 * (i)))
constexpr int I_IN0 = 16 * 72, I_QUP = 6 * 24, I_KVUP = 4 * 32, I_OUT = 16 * 32, I_GU = 16 * 224, I_D = 56 * 32;
constexpr int P0_NITEMS = I_IN0 + I_QUP + I_KVUP + I_OUT + I_GU + I_D + I_IN0 + I_OUT + 8 * I_GU + 8 * I_D;
__device__ __forceinline__ void p0_desc(TrDesc& d, unsigned char* ws, int it, int lane) {
    int r = it;
    if (r < 8 * I_GU) { const int e = r / I_GU; r -= e * I_GU; const size_t wo = (size_t)e * 1024 * DFF;
        tr_desc(d, MapGU{P0_IN(21) + wo, P0_IN(22) + wo}, P0_IN(19), 1024, 7168, (bf16*)(ws + WS_WMOE_GU + (size_t)e * 7168 * 1024), r, lane); d.f8 = 1; return; } r -= 8 * I_GU;
    if (r < 8 * I_D) { const int e = r / I_D; r -= e * I_D; tr_desc(d, MapId{P0_IN(23) + (size_t)e * DFF * 1024, 1024}, (const float*)nullptr, DFF, 1024, (bf16*)(ws + WS_WMOE_D + (size_t)e * 1024 * DFF), r, lane); d.f8 = 1; return; } r -= 8 * I_D;
    if (r < I_IN0) { tr_desc(d, MapIn0{P0_IN(3)}, (const float*)nullptr, 1024, 2304, (bf16*)(ws + WS_W_IN0), r, lane); return; } r -= I_IN0;
    if (r < I_QUP) { tr_desc(d, MapQup{P0_IN(6)}, P0_IN(5), 384, 768, (bf16*)(ws + WS_W_QUP), r, lane); return; } r -= I_QUP;
    if (r < I_KVUP) { tr_desc(d, MapId{P0_IN(8), 1024}, P0_IN(7), 256, 1024, (bf16*)(ws + WS_W_KVUP), r, lane); return; } r -= I_KVUP;
    if (r < I_OUT) { tr_desc(d, MapId{P0_IN(9), 1024}, (const float*)nullptr, 1024, 1024, (bf16*)(ws + WS_W_OUT0), r, lane); return; } r -= I_OUT;
    if (r < I_GU) { tr_desc(d, MapGU{P0_IN(11), P0_IN(12)}, P0_IN(10), 1024, 7168, (bf16*)(ws + WS_W_GU0), r, lane); return; } r -= I_GU;
    if (r < I_D) { tr_desc(d, MapId{P0_IN(13), 1024}, (const float*)nullptr, DFF, 1024, (bf16*)(ws + WS_W_D0), r, lane); return; } r -= I_D;
    if (r < I_IN0) { tr_desc(d, MapIn1{P0_IN(15)}, P0_IN(14), 1024, 2304, (bf16*)(ws + WS_W_IN1), r, lane); d.f8 = IN1_FP8; return; } r -= I_IN0;
    tr_desc(d, MapId{P0_IN(18), 1024}, (const float*)nullptr, 1024, 1024, (bf16*)(ws + WS_W_OUT1), r, lane);
}
__device__ __forceinline__ void tr_items(const Frame& F, unsigned char* ws, int first, int last, int w, int nworkers) {
    const int lane = F.lane, wave = F.wave;
    LAS float* scr = (LAS float*)(F.lds + RING_OFF + wave * 16384);
    const int NGW = nworkers * NWAVES;
    TrDesc d0, d1, d2, d3; f32x4 v0[8], v1[8], v2[8], v3[8]; int it = first + w * NWAVES + wave;
#define TR_LD(s, idx) do { const int i_ = (idx); if (i_ < last) { p0_desc(d##s, ws, i_, lane); tr_load(d##s, v##s, lane); } } while (0)
    TR_LD(0, it); TR_LD(1, it + NGW); TR_LD(2, it + 2 * NGW);
    while (it < last) {
        TR_LD(3, it + 3 * NGW); tr_finish(d0, v0, scr, lane); it += NGW; if (it >= last) break;
        TR_LD(0, it + 3 * NGW); tr_finish(d1, v1, scr, lane); it += NGW; if (it >= last) break;
        TR_LD(1, it + 3 * NGW); tr_finish(d2, v2, scr, lane); it += NGW; if (it >= last) break;
        TR_LD(2, it + 3 * NGW); tr_finish(d3, v3, scr, lane); it += NGW;
    }
#undef TR_LD
}
#ifndef BG_PER_WAVE
#define BG_PER_WAVE 6
#endif
constexpr int BG_HALF = 128 * NWAVES * BG_PER_WAVE, BG_ITEMS = 2 * BG_HALF;
__device__ __forceinline__ void p0_prologue(Frame& F, unsigned char* ws) {
    const int gw = F.vcu * NWAVES + F.wave, NGW = F.G * NWAVES;
#if defined(PROBE_DUP) && defined(P0_DUP_PART)
#define P0_PART(k) ((P0_DUP_PART >> (k)) & 1)
#else
#define P0_PART(k) 1
#endif
    if (P0_PART(0)) tr_items(F, ws, BG_ITEMS, P0_NITEMS, F.vcu, F.G);
    const int* pos = (const int*)P0_IN(1);
    const int gt = F.vcu * (NWAVES * 64) + F.tid, NGT = F.G * NWAVES * 64;
    if (P0_PART(1)) for (int idx = gt; idx < NTOK * 48; idx += NGT) {
        const int tok = idx / 48, j = idx % 48; const bool m = j < 16; const int i = m ? j : j - 16;
        const float ang = (float)pos[tok] * INV_FREQ64[m ? 2 * i : i];
        float sn_, cn_; sincosf(ang, &sn_, &cn_); f32x2 cs; cs.x = cn_; cs.y = sn_;
        if (m) *(f32x2*)(ws + WS_CSM + ((size_t)tok * 16 + i) * 8) = cs; else *(f32x2*)(ws + WS_CSS + ((size_t)tok * 32 + i) * 8) = cs;
    }
    const float* g0 = P0_IN(2);
    if (P0_PART(2)) for (int m = gw; m < NTOK; m += NGW) {
        const GAS f32x4* xr = (const GAS f32x4*)(P0_IN(0) + (size_t)m * DM) + F.lane;
        f32x4 v[4]; float s = 0.f;
#pragma unroll
        for (int j = 0; j < 4; ++j) { v[j] = xr[64 * j]; s += (v[j].x * v[j].x + v[j].y * v[j].y) + (v[j].z * v[j].z + v[j].w * v[j].w); }
        const float rstd = 1.f / sqrtf(wave_sum(s) * (1.f / DM) + RMS_EPS);
        GAS unsigned long long* o8 = (GAS unsigned long long*)((bf16*)(ws + WS_XB) + (size_t)m * DM) + F.lane;
#pragma unroll
        for (int j = 0; j < 4; ++j) { const f32x4 g = *((const f32x4*)g0 + F.lane + 64 * j);
            o8[64 * j] = (unsigned long long)pk2(v[j].x * rstd * g.x, v[j].y * rstd * g.y) | ((unsigned long long)pk2(v[j].z * rstd * g.z, v[j].w * rstd * g.w) << 32); }
    }
}

__device__ __forceinline__ float fox_norm1(const v4u (&w)[8]) { float s = 0.f;
#pragma unroll
    for (int c = 0; c < 8; ++c)
#pragma unroll
        for (int e = 0; e < 4; ++e) { const float lo = bf2f(w[c][e] & 0xffffu), hi = bf2f(w[c][e] >> 16); s += lo * lo + hi * hi; }
#pragma unroll
    for (int o = 1; o < 64; o <<= 1) s = fmaxf(s, shx(s, o));
    return sqrtf(s) * 1.0001f; }
__device__ __forceinline__ void fox_norms(Frame& F, const bf16* FQ, const bf16* FK, float* FAUX, int w, int nworkers) {
    const int gw = w * NWAVES + F.wave, NGW = nworkers * NWAVES;
#define FOXN_SRC(it) (((it) >> 12 ? FQ : FK) + ((size_t)(((((it) >> 7) & 31) >> 3) * SEQ + 64 * ((it) & 127) + F.lane)) * 512 + ((((it) >> 7) & 31) & 7) * 64)
#define FOXN_DST(it) FAUX[(size_t)(((it) >> 7) & 31) * 512 + ((it) >> 12 ? 384 : 0) + ((it) & 127)]
    for (int it = gw; it < 8192; it += 2 * NGW) {
        const int it2 = it + NGW; const bool two = it2 < 8192;
        v4u wa[8], wb[8]; const bf16* sa = FOXN_SRC(it); const bf16* sb = FOXN_SRC(two ? it2 : it);
#pragma unroll
        for (int c = 0; c < 8; ++c) { wa[c] = *(const v4u*)(sa + 8 * c); wb[c] = *(const v4u*)(sb + 8 * c); }
        const float na = fox_norm1(wa), nb = fox_norm1(wb);
        if (F.lane == 0) { FOXN_DST(it) = na; if (two) FOXN_DST(it2) = nb; }
    }
#undef FOXN_SRC
#undef FOXN_DST
}
__device__ __forceinline__ void fox_cumsum(Frame& F, const float* FL, const float* bforget, bf16* KB, float* FAUX, int b, int h) {
    const float bh = bforget[h]; const int t0 = 16 * F.tid;
    float ls[16]; double loc = 0.0;
#pragma unroll
    for (int i = 0; i < 16; ++i) { const float z = FL[((size_t)(b * SEQ + t0 + i)) * 8 + h] + bh; const float l = fminf(z, 0.f) - log1pf(expf(-fabsf(z))); loc += (double)l; ls[i] = (float)loc; }
    double inc = loc;
#pragma unroll
    for (int o = 1; o < 64; o <<= 1) {
        const int src = ((F.lane >= o) ? F.lane - o : F.lane) << 2; const long long iv = __builtin_bit_cast(long long, inc);
        const unsigned lo = (unsigned)__builtin_amdgcn_ds_bpermute(src, (int)(unsigned)iv), hi = (unsigned)__builtin_amdgcn_ds_bpermute(src, (int)(unsigned)(iv >> 32));
        const double t = __builtin_bit_cast(double, (long long)(((unsigned long long)hi << 32) | lo)); if (F.lane >= o) inc += t; }
    LAS double* wt = (LAS double*)(F.lds + RING_OFF);
    if (F.lane == 63) wt[F.wave] = inc;
    __syncthreads();
    double base = 0.0;
#pragma unroll
    for (int w = 0; w < 8; ++w) if (w < F.wave) base += wt[w];
    const double excl = base + inc - loc;
    float bmx = -INFINITY, bmn = INFINITY;
#pragma unroll
    for (int i = 0; i < 16; ++i) {
        const float v = -(float)(excl + (double)ls[i]) * LOG2E; bmx = fmaxf(bmx, v); bmn = fminf(bmn, v);
        const unsigned hi = f2bf(v); const float r1 = v - bf2f(hi); const unsigned mid = f2bf(r1); const float r2 = r1 - bf2f(mid); const unsigned lo = f2bf(r2);
        v4u w0; w0.x = hi | (mid << 16); w0.y = lo; w0.z = 0u; w0.w = 0u; const v4u z4 = {0u, 0u, 0u, 0u};
        bf16* dst = KB + ((size_t)(b * SEQ + t0 + i) * 8 + h) * 16;
        *(v4u*)dst = w0; *(v4u*)(dst + 8) = z4;
    }
    bmx = fmaxf(bmx, shx(bmx, 1)); bmx = fmaxf(bmx, shx(bmx, 2)); bmn = fminf(bmn, shx(bmn, 1)); bmn = fminf(bmn, shx(bmn, 2));
    if ((F.tid & 3) == 0) { float* fa = FAUX + (size_t)(b * 8 + h) * 512 + (F.tid >> 2); fa[128] = bmx + 1e-3f; fa[256] = bmn - 1e-3f; }
    __syncthreads();
}

__device__ __forceinline__ void conv_phase(Frame& F, const bf16* GB, const bf16* U, const float* cw, bf16* MIX1) {
    const int gt = F.vcu * (NWAVES * 64) + F.tid, NGT = F.G * NWAVES * 64;
    for (int idx = gt; idx < NTOK * 64; idx += NGT) {
        const int tok = idx >> 6, c8 = (idx & 63) * 8, t = tok & (SEQ - 1);
        const v4u gb = *(const v4u*)(GB + (size_t)tok * 512 + c8), u2 = *(const v4u*)(U + (size_t)tok * 512 + c8);
        v4u u1 = {0u, 0u, 0u, 0u}, u0 = {0u, 0u, 0u, 0u};
        if (t >= 1) u1 = *(const v4u*)(U + (size_t)(tok - 1) * 512 + c8);
        if (t >= 2) u0 = *(const v4u*)(U + (size_t)(tok - 2) * 512 + c8);
        float o[8];
#pragma unroll
        for (int e = 0; e < 8; ++e) { const int sh = (e & 1) * 16; const unsigned m = 0xffffu;
            const float g = bf2f((gb[e >> 1] >> sh) & m), a0 = bf2f((u0[e >> 1] >> sh) & m), a1 = bf2f((u1[e >> 1] >> sh) & m), a2 = bf2f((u2[e >> 1] >> sh) & m);
            o[e] = g * (cw[c8 + e] * a0 + cw[512 + c8 + e] * a1 + cw[1024 + c8 + e] * a2); }
        v4u w; w.x = pk2(o[0], o[1]); w.y = pk2(o[2], o[3]); w.z = pk2(o[4], o[5]); w.w = pk2(o[6], o[7]);
        *(v4u*)(MIX1 + (size_t)tok * 1024 + 512 + c8) = w;
    }
}

__device__ __forceinline__ void router_phase(Frame& F, const bf16* h3, const float* gnorm, const float* wr, ListEnt* LIST, gu32* ctl) {
    float wq[4][4][8];
#pragma unroll
    for (int j = 0; j < 4; ++j)
#pragma unroll
        for (int e = 0; e < 4; ++e) { const int k = 256 * j + 4 * F.lane + e; const float g = gnorm[k];
#pragma unroll
            for (int x = 0; x < 8; ++x) wq[j][e][x] = g * wr[k * 8 + x]; }
    LAS float* info = (LAS float*)(F.lds + RING_OFF);
    LAS unsigned* cl = (LAS unsigned*)(F.lds + RING_OFF + 8192);
    if (F.tid < 32) cl[F.tid] = 0u;
    __syncthreads();
    const int row0 = (int)blockIdx.x * 128;
    for (int j = 0; j < 16; ++j) {
        const int lr = F.wave * 16 + j, row = row0 + lr;
        const GAS unsigned long long* xr = (const GAS unsigned long long*)(h3 + (size_t)row * DM) + F.lane;
        float s = 0.f, lg[8];
#pragma unroll
        for (int x = 0; x < 8; ++x) lg[x] = 0.f;
#pragma unroll
        for (int q = 0; q < 4; ++q) { const unsigned long long w_ = xr[64 * q]; const unsigned lo_ = (unsigned)w_, hi_ = (unsigned)(w_ >> 32);
            f32x4 v; v.x = __uint_as_float(lo_ << 16); v.y = __uint_as_float(lo_ & 0xffff0000u); v.z = __uint_as_float(hi_ << 16); v.w = __uint_as_float(hi_ & 0xffff0000u); s += (v.x * v.x + v.y * v.y) + (v.z * v.z + v.w * v.w);
#pragma unroll
            for (int x = 0; x < 8; ++x) lg[x] += (v.x * wq[q][0][x] + v.y * wq[q][1][x]) + (v.z * wq[q][2][x] + v.w * wq[q][3][x]); }
        const float rstd = 1.f / sqrtf(wave_sum(s) * (1.f / DM) + RMS_EPS);
#pragma unroll
        for (int x = 0; x < 8; ++x) lg[x] = wave_sum(lg[x]) * rstd;
        int i0 = 0; float m0 = lg[0];
#pragma unroll
        for (int x = 1; x < 8; ++x) if (lg[x] > m0) { m0 = lg[x]; i0 = x; }
        int i1 = -1; float m1 = -INFINITY;
#pragma unroll
        for (int x = 0; x < 8; ++x) if (x != i0 && lg[x] > m1) { m1 = lg[x]; i1 = x; }
        const float w1 = 1.0f / (1.0f + expf(m0 - m1)), w0 = 1.0f - w1;
        if (F.lane == 0) { info[lr * 8 + 0] = __int_as_float(i0); info[lr * 8 + 1] = __int_as_float(i1); info[lr * 8 + 2] = w0; info[lr * 8 + 3] = w1; info[lr * 8 + 4] = rstd; }
    }
    __syncthreads();
    int e = 0, sl = 0; const int lr = F.tid >> 1, k = F.tid & 1;
    if (F.tid < 256) { e = __float_as_int(info[lr * 8 + k]); sl = (int)atomicAdd((unsigned*)(cl + k * 8 + e), 1u); }
    __syncthreads();
    if (F.tid < 16) cl[16 + F.tid] = __hip_atomic_fetch_add(ctl + CW_CNT + 64 * F.tid, cl[F.tid], RLX_AGENT);
    __syncthreads();
    if (F.tid < 256) { const int slot = (int)cl[16 + k * 8 + e] + sl; ListEnt en; en.tok = row0 + lr; en.gw = info[lr * 8 + 2 + k]; en.rs = info[lr * 8 + 4]; en.pad = 0;
        LIST[((size_t)(k * 8 + e)) * NTOK + slot] = en; }
    __syncthreads();
}

struct MoeOrder {
    pg8::StaticOrder so; int nN; const LAS int* tab; const ListEnt* list; int ufull, rem, ns, part;
    __device__ __forceinline__ void init(LAS int* tab_, const gu32* ctl, const ListEnt* list_, int nN_, int G, int c, bool splitk, bool t0  ) {
        list = list_; nN = nN_; tab = tab_;
        __syncthreads();
        if (t0) { int acc = 0;
            for (int li = 0; li < 16; ++li) { const int ce = (int)__hip_atomic_load(ctl + CW_CNT + 64 * li, RLX_AGENT); tab_[li] = ce; tab_[16 + li] = acc; acc += (ce + 255) >> 8; }
            tab_[32] = acc; }
        __syncthreads();
        int tot = __builtin_amdgcn_readfirstlane(tab_[32]); if (tot > MOE_CAP) tot = MOE_CAP;
        so.init(tot, nN, G, c);
        part = 0; ufull = splitk ? (so.nwg / G) * G : so.nwg; rem = so.nwg - ufull; ns = (7 * rem <= SLAB_CAP) ? 7 : 2;
    }
    __device__ __forceinline__ void unit_of(int lp, int pn, pg8::Unit& u) const {
        int li = 0;
#pragma unroll
        for (int x = 1; x < 16; ++x) if (lp >= __builtin_amdgcn_readfirstlane(tab[16 + x])) li = x;
        const int j = lp - __builtin_amdgcn_readfirstlane(tab[16 + li]); int nv = __builtin_amdgcn_readfirstlane(tab[li]) - 256 * j; if (nv > 256) nv = 256;
        u.pa = lp; u.pb = (li & 7) * nN + pn; u.pm = lp; u.pn = pn; u.e = li; u.nv = nv; u.s0 = 256 * j;
    }
    __device__ __forceinline__ bool next(int i, pg8::Unit& u) const {
        long L = (long)i * so.G + so.c; int lp, pn;
        if (L < ufull) { if (!so.tile_lin(L, lp, pn)) return false; unit_of(lp, pn, u); u.kt0 = 0; u.ntu = DFF / 128; u.slab = -1; return true; }
        const int q = (int)(L - ufull); if (q >= ns * rem) return false;
        const int r = q / ns, ks = q - r * ns, ntu = (DFF / 128) / ns;
        so.tile_lin((long)ufull + r, lp, pn); unit_of(lp, pn, u); u.kt0 = ntu * ks; u.ntu = ntu; u.slab = q; return true;
    }
    __device__ __forceinline__ void fill(const pg8::Unit& u, LAS unsigned* dst, int wid, int lane) const {
        if (wid < 4) __builtin_amdgcn_global_load_lds((const unsigned*)&list[(size_t)u.e * NTOK + u.s0 + wid * 64 + lane].tok, dst + wid * 64, 4, 0, 0);
    }
};
__device__ __forceinline__ void moe_combine(Frame& F, const MoeOrder& S, const float* slabs, bf16* xb, bf16* y0) {
    const int gw = F.vcu * NWAVES + F.wave, NGW = F.G * NWAVES;
    for (int it = gw; it < S.rem * 256; it += NGW) {
        const int r = it >> 8, row = it & 255; int lp, pn; pg8::Unit u; S.so.tile_lin((long)S.ufull + r, lp, pn); S.unit_of(lp, pn, u);
        if (row >= u.nv) continue;
        const ListEnt en = S.list[(size_t)u.e * NTOK + u.s0 + row];
        const float* sp = slabs + ((size_t)(S.ns * r) * 256 + row) * 256 + 4 * F.lane;
        f32x4 s = *(const f32x4*)sp + *(const f32x4*)(sp + 65536);
        if (S.ns == 7) s = (s + (*(const f32x4*)(sp + 2 * 65536) + *(const f32x4*)(sp + 3 * 65536))) + ((*(const f32x4*)(sp + 4 * 65536) + *(const f32x4*)(sp + 5 * 65536)) + *(const f32x4*)(sp + 6 * 65536));
        s = s * (W8_INV * en.gw);
        const size_t off = (size_t)en.tok * DM + pn * 256 + 4 * F.lane;
        f32x4 o = s;
        if (u.e >= 8) { const unsigned long long w_ = *(const unsigned long long*)(xb + off); const unsigned lo_ = (unsigned)w_, hi_ = (unsigned)(w_ >> 32);
            o = o + (f32x4){__uint_as_float(lo_ << 16), __uint_as_float(lo_ & 0xffff0000u), __uint_as_float(hi_ << 16), __uint_as_float(hi_ & 0xffff0000u)}; }
        *(unsigned long long*)((u.e >= 8 ? xb : y0) + off) = (unsigned long long)pk2(o[0], o[1]) | ((unsigned long long)pk2(o[2], o[3]) << 32);
    }
}
constexpr int NPH = 16;
#ifndef RES_SKEW
#define RES_SKEW 0
#endif
__device__ __forceinline__ bool in_phase(int k, int lo, int hi) { asm volatile("" : "+s"(lo), "+s"(hi)); return lo <= k && k < hi; }
static_assert(sizeof(Args) == 25 * 8 + 8 + 8 + 8, "Args has no padding");
__global__ void __launch_bounds__(NWAVES * 64, 2) skel_fwd(Args args) {
    extern __shared__ __attribute__((aligned(16))) unsigned char lds[];
    Frame F;
    F.lds = (LAS unsigned char*)lds;
    F.MISC = (volatile LAS unsigned*)(F.lds + MISC_OFF);
    const int wave0 = __builtin_amdgcn_readfirstlane((int)threadIdx.x >> 6);
#define FRAME_TID() do { int t_ = wave0 * 64 + lane_id(); asm volatile("" : "+v"(t_)); F.tid = t_; F.lane = t_ & 63; F.wave = __builtin_amdgcn_readfirstlane(t_ >> 6); \
        int g_ = gridDim.x, bx_ = blockIdx.x; asm volatile("" : "+s"(g_), "+s"(bx_)); F.G = g_; F.vcu = (g_ % 8 == 0) ? (bx_ % 8) * (g_ / 8) + bx_ / 8 : bx_; } while (0)
    FRAME_TID();
    typedef __attribute__((address_space(4))) const unsigned char* kptr_t;
#define KARG() ({ kptr_t kp_ = (kptr_t)__builtin_amdgcn_kernarg_segment_ptr(); asm volatile("" : "+s"(kp_)); kp_; })
#define ARG_IN(i) (*(const float* const __attribute__((address_space(4)))*)(KARG() + 8 * (i)))
#define ARG_OUT() (*(float* const __attribute__((address_space(4)))*)(KARG() + 200))
#define ARG_WS() (*(unsigned char* const __attribute__((address_space(4)))*)(KARG() + 208))
#define ARG_LO() (*(const int __attribute__((address_space(4)))*)(KARG() + 216))
#define ARG_HI() (*(const int __attribute__((address_space(4)))*)(KARG() + 220))
#define ws (ARG_WS())
#define FCTL ((gu32*)(ws + WS_CTL))
    for (int u = F.tid; u < (LDS_BYTES - LDSCTL_OFF) / 4; u += NWAVES * 64) ((LAS unsigned*)(F.lds + LDSCTL_OFF))[u] = 0u;
    __syncthreads();
    XcdBarrier bar = xcd_barrier_post((unsigned*)(FCTL + CW_BAR), F.MISC + 8, F.tid == 0);
    const int lo = ARG_LO(), hi = ARG_HI();
#ifndef PH_MASK
#define PH_MASK 0xFFFF
#endif
#define IN(k) (((PH_MASK >> (k)) & 1) && in_phase((k), lo, hi))
#define SEAM(k) do { if (IN(k) && IN((k) + 1)) { FRAME_TID(); xcd_barrier(bar, F.tid == 0); } } while (0)
#define dob ((unsigned char*)ARG_OUT())
#define ssq_q ((float*)(ws + WS_PQ))
#define ssq_kv ((float*)(ws + WS_PKV))
#define ssq_h1 ((float*)(ws + WS_PH))
#define ssq_h2 ((float*)(ws + WS_PH))
#define XB ((bf16*)(ws + WS_XB))
#define bid ((int)blockIdx.x)

#ifdef DIAG_PH
#define TSTAMP(slot) do { if (blockIdx.x == 0 && wave0 == 0 && lane_id() == 0) ((unsigned long long*)(ws + WS_CTL + 49152))[8 + (slot)] = __builtin_amdgcn_s_memrealtime(); } while (0)
#else
#define TSTAMP(slot) do { } while (0)
#endif
    TSTAMP(0);
    if (IN(0)) { FRAME_TID(); p0_prologue(F, ws); }
    SEAM(0); TSTAMP(1);
    if (IN(1)) { FRAME_TID();
        pg8::StaticOrder S; S.init(NTOK / 256, 9, F.G, bid);
        ep::EpiIn0 E{(bf16*)(dob + DO_FQ), (bf16*)(dob + DO_CKV), (bf16*)(ws + WS_CQ), (bf16*)(ws + WS_KPE), (float*)(ws + WS_FL), ssq_q, ssq_kv, (const float*)(ws + WS_CSM)};
        pg8::gemm_phase<ep::EpiIn0, pg8::StaticOrder, false>(F.lds + RING_OFF, F.wave, XB, (const bf16*)(ws + WS_W_IN0), 1024, S, E);
        if (BG_ITEMS > 0 && F.G == 256 && bid >= 128) tr_items(F, ws, 0, BG_HALF, bid - 128, 128);
        else if (BG_ITEMS > 0 && F.G != 256) tr_items(F, ws, 0, BG_HALF, bid, F.G);
    }
    SEAM(1); TSTAMP(2);
    if (IN(2)) { FRAME_TID();
#if defined(PROBE_DUP) && defined(P2_DUP_PARTS)
#define P2_PARTS P2_DUP_PARTS
#else
#define P2_PARTS 15
#endif
        if (P2_PARTS & 8) { if (F.G == 256) { if (bid >= 160) fox_norms(F, (const bf16*)(dob + DO_FQ), (const bf16*)(dob + DO_FK), (float*)(ws + WS_FAUX), bid - 160, 96); }
                            else fox_norms(F, (const bf16*)(dob + DO_FQ), (const bf16*)(dob + DO_FK), (float*)(ws + WS_FAUX), bid, F.G); }
        if ((P2_PARTS & 1) && bid >= 128 && bid < 160) fox_cumsum(F, (const float*)(ws + WS_FL), ARG_IN(4), (bf16*)(dob + DO_KB), (float*)(ws + WS_FAUX), (bid - 128) >> 3, (bid - 128) & 7);
        if (P2_PARTS & 2) { pg8::StaticOrder S; S.init(NTOK / 256, 3, F.G, bid);
          ep::EpiQup E{(bf16*)(ws + WS_MQ), ssq_q, (const float*)(ws + WS_CSM)};
          pg8::gemm_phase<ep::EpiQup, pg8::StaticOrder, false>(F.lds + RING_OFF, F.wave, (const bf16*)(ws + WS_CQ), (const bf16*)(ws + WS_W_QUP), 384, S, E); }
        if (P2_PARTS & 4) { pg8::StaticOrder S; S.init(NTOK / 256, 4, F.G, bid);
          ep::EpiKVup E{(bf16*)(ws + WS_MKV), ssq_kv};
          pg8::gemm_phase<ep::EpiKVup, pg8::StaticOrder, false>(F.lds + RING_OFF, F.wave, (const bf16*)(dob + DO_CKV), (const bf16*)(ws + WS_W_KVUP), 256, S, E); }
    }
#undef P2_PARTS
    SEAM(2); TSTAMP(3);
    if (IN(3)) { FRAME_TID();
        const int bh = F.vcu >> 3, s = F.vcu & 7, b = bh >> 3, h = bh & 7; const size_t rb = (size_t)b * SEQ;
        bf16* MIX0 = (bf16*)(ws + WS_MIX0);
#if !defined(PROBE_DUP) || !defined(P3_DUP_PART) || (P3_DUP_PART & 1)
        { att::Ptrs A; const bf16* FQ = (const bf16*)(dob + DO_FQ); const bf16* FK = (const bf16*)(dob + DO_FK); const bf16* FV = (const bf16*)(dob + DO_FV); const bf16* KB = (const bf16*)(dob + DO_KB);
          A.Qm = FQ + rb * 512 + h * 64; A.qp = 512; A.Qx = nullptr; A.qxp = 0; A.Km = FK + rb * 512 + h * 64; A.kp = 512; A.Kx = KB + rb * 128 + h * 16; A.kxp = 128;
          A.V = FV + rb * 512 + h * 64; A.vp = 512; A.O = MIX0 + rb * 1024 + h * 64; A.op = 1024; A.aux = (const float*)(ws + WS_FAUX) + (size_t)bh * 512;
#pragma nounroll
          for (int i = 0; i < 4; ++i) { const int qb = (i == 0) ? s : (i == 1) ? 15 - s : (i == 2) ? 16 + s : 31 - s; att::attn_unit<5, 0, true>(A, qb * 256, 0.f, (char*)lds + RING_OFF, F.wave); } }
#endif
#if !defined(PROBE_DUP) || !defined(P3_DUP_PART) || (P3_DUP_PART & 2)
        { att::Ptrs A; const bf16* MQ = (const bf16*)(ws + WS_MQ); const bf16* MKV = (const bf16*)(ws + WS_MKV); const bf16* KPE = (const bf16*)(ws + WS_KPE);
          A.Qm = MQ + rb * 768 + h * 96; A.qp = 768; A.Qx = A.Qm + 64; A.qxp = 768; A.Km = MKV + rb * 1024 + h * 128; A.kp = 1024; A.Kx = KPE + rb * 32; A.kxp = 32;
          A.V = MKV + rb * 1024 + h * 128 + 64; A.vp = 1024; A.O = MIX0 + rb * 1024 + 512 + h * 64; A.op = 1024;
#pragma nounroll
          for (int i = 0; i < 4; ++i) { const int qb = (i == 0) ? s : (i == 1) ? 15 - s : (i == 2) ? 16 + s : 31 - s; att::attn_unit<6, 0, false>(A, qb * 256, 0.f, (char*)lds + RING_OFF, F.wave); } }
#endif
    }
    SEAM(3); TSTAMP(4);
    if (IN(4)) { FRAME_TID();
        pg8::StaticOrder S; S.init(NTOK / 256, 4, F.G, bid);
        ep::EpiRes<false, false> E{ARG_IN(0), nullptr, nullptr, XB, ssq_h1, nullptr};
        pg8::gemm_phase<ep::EpiRes<false, false>, pg8::StaticOrder, false>(F.lds + RING_OFF, F.wave, (const bf16*)(ws + WS_MIX0), (const bf16*)(ws + WS_W_OUT0), 1024, S, E, nullptr, RES_SKEW);
    }
    SEAM(4); TSTAMP(5);
    if (IN(5)) { FRAME_TID();
        pg8::StaticOrder S; S.init(NTOK / 256, 28, F.G, bid);
#if defined(PROBE_DUP) && defined(P5_DUP_MODE)
        ep::EpiGU E{(bf16*)(ws + WS_HID0), ssq_h1, P5_DUP_MODE};
#else
        ep::EpiGU E{(bf16*)(ws + WS_HID0), ssq_h1, 0};
#endif
        { int last = -1;
#pragma nounroll
          for (int i = 0; ; ++i) { int pm, pn; if (!S.tile(i, pm, pn)) break; if (pm != last) { rstd_rows(F, ssq_h1, ssq_q, pm); last = pm; } }
          VM_WAIT(); __syncthreads(); }
        E.part = ssq_q;
#ifdef PG8_DIAG
        pg8::gemm_phase<ep::EpiGU, pg8::StaticOrder, false>(F.lds + RING_OFF, F.wave, XB, (const bf16*)(ws + WS_W_GU0), 1024, S, E, (bid == 0) ? (unsigned long long*)(ws + WS_CTL + 49152) : nullptr);
#else
        pg8::gemm_phase<ep::EpiGU, pg8::StaticOrder, false>(F.lds + RING_OFF, F.wave, XB, (const bf16*)(ws + WS_W_GU0), 1024, S, E);
#endif
    }
    SEAM(5); TSTAMP(6);
    if (IN(6)) { FRAME_TID();
        pg8::StaticOrder S; S.init(NTOK / 256, 4, F.G, bid);
        ep::EpiRes<true, false> E{nullptr, XB, nullptr, XB, ssq_h2, IN1_FP8 ? ws + WS_XB8 : nullptr};
        pg8::gemm_phase<ep::EpiRes<true, false>, pg8::StaticOrder, false, false, true>(F.lds + RING_OFF, F.wave, (const bf16*)(ws + WS_HID0), (const bf16*)(ws + WS_W_D0), DFF, S, E);
    }
    SEAM(6); TSTAMP(7);
    if (IN(7)) { FRAME_TID();
        pg8::StaticOrder S; S.init(NTOK / 256, 9, F.G, bid);
        ep::EpiIn1 E{(bf16*)(ws + WS_SQ), (bf16*)(ws + WS_SK), (bf16*)(ws + WS_SV), (bf16*)(ws + WS_GB), (bf16*)(ws + WS_U), ssq_h2, (const float*)(ws + WS_CSS)};
#if IN1_FP8
        pg8::gemm_phase<ep::EpiIn1, pg8::StaticOrder, false, false, false, 2>(F.lds + RING_OFF, F.wave, (const bf16*)(ws + WS_XB8), (const bf16*)(ws + WS_W_IN1), 512, S, E);
#else
        pg8::gemm_phase<ep::EpiIn1, pg8::StaticOrder, false>(F.lds + RING_OFF, F.wave, XB, (const bf16*)(ws + WS_W_IN1), 1024, S, E);
#endif
        if (BG_ITEMS > 0 && F.G == 256 && bid >= 128) tr_items(F, ws, BG_HALF, BG_ITEMS, bid - 128, 128);
        else if (BG_ITEMS > 0 && F.G != 256) tr_items(F, ws, BG_HALF, BG_ITEMS, bid, F.G);
    }
    SEAM(7); TSTAMP(8);
    if (IN(8)) { FRAME_TID();
        bf16* MIX1 = (bf16*)(ws + WS_MIX1);
        if (bid & 1) { conv_phase(F, (const bf16*)(ws + WS_GB), (const bf16*)(ws + WS_U), ARG_IN(17), MIX1); __syncthreads(); }
#pragma nounroll
        for (int i = 0; i < 4; ++i) {
            const int L = F.vcu * 4 + i, qb = L & 31, hq = (L >> 5) & 7, b = L >> 8; const size_t rb = (size_t)b * SEQ;
            att::Ptrs A; A.Qm = (const bf16*)(ws + WS_SQ) + rb * 512 + hq * 64; A.qp = 512; A.Qx = nullptr; A.qxp = 0; A.Km = (const bf16*)(ws + WS_SK) + rb * 128 + (hq >> 2) * 64; A.kp = 128; A.Kx = nullptr; A.kxp = 0;
            A.V = (const bf16*)(ws + WS_SV) + rb * 128 + (hq >> 2) * 64; A.vp = 128; A.O = MIX1 + rb * 1024 + hq * 64; A.op = 1024;
            att::attn_unit<4, 1, false>(A, qb * 256, ARG_IN(16)[hq] * LOG2E, (char*)lds + RING_OFF, F.wave);
        }
        if (!(bid & 1)) { FRAME_TID(); conv_phase(F, (const bf16*)(ws + WS_GB), (const bf16*)(ws + WS_U), ARG_IN(17), MIX1); }
    }
    SEAM(8); TSTAMP(9);
    if (IN(9)) { FRAME_TID();
        pg8::StaticOrder S; S.init(NTOK / 256, 4, F.G, bid);
        ep::EpiRes<true, false> E{nullptr, XB, nullptr, XB, nullptr, ws + WS_XB8};
        pg8::gemm_phase<ep::EpiRes<true, false>, pg8::StaticOrder, false>(F.lds + RING_OFF, F.wave, (const bf16*)(ws + WS_MIX1), (const bf16*)(ws + WS_W_OUT1), 1024, S, E, nullptr, RES_SKEW);
    }
    SEAM(9); TSTAMP(10);
#define LIST ((ListEnt*)(ws + WS_LIST))
    if (IN(10)) { FRAME_TID(); router_phase(F, XB, ARG_IN(19), ARG_IN(20), LIST, FCTL); }
    SEAM(10); TSTAMP(11);
#define Y0 ((bf16*)(ws + WS_Y0))
    if (IN(11)) { FRAME_TID();
        MoeOrder S; S.init((LAS int*)(F.lds + LDSCTL_OFF), FCTL, LIST, 28, F.G, bid, false, F.tid == 0);
        ep::EpiMoe1 E{(bf16*)(ws + WS_HID1), LIST};
        pg8::gemm_phase<ep::EpiMoe1, MoeOrder, true, false, false, 2>(F.lds + RING_OFF, F.wave, (const bf16*)(ws + WS_XB8), (const bf16*)(ws + WS_WMOE_GU), 512, S, E);
    }
    SEAM(11); TSTAMP(12);
    if (IN(12)) { FRAME_TID();
        MoeOrder S; S.init((LAS int*)(F.lds + LDSCTL_OFF), FCTL, LIST, 4, F.G, bid, true, F.tid == 0);
        ep::EpiMoe2 E{XB, Y0, LIST, ARG_OUT()};
        pg8::gemm_phase<ep::EpiMoe2, MoeOrder, false, true, true, 2>(F.lds + RING_OFF, F.wave, (const bf16*)(ws + WS_HID1), (const bf16*)(ws + WS_WMOE_D), DFF / 2, S, E);
    }
    SEAM(12); TSTAMP(13);
    if (IN(13)) { FRAME_TID();
        MoeOrder S1; S1.init((LAS int*)(F.lds + LDSCTL_OFF), FCTL, LIST, 4, F.G, bid, true, F.tid == 0); moe_combine(F, S1, ARG_OUT(), XB, Y0);
    }
    SEAM(13); TSTAMP(14);
    if (IN(14)) { FRAME_TID();
        const int gw = F.vcu * NWAVES + F.wave, NGW = F.G * NWAVES; const float* gf = ARG_IN(24);
        for (int m = gw; m < NTOK; m += NGW) {
            const GAS unsigned long long* xs = (const GAS unsigned long long*)(XB + (size_t)m * DM) + F.lane;
            const GAS unsigned long long* ys = (const GAS unsigned long long*)(Y0 + (size_t)m * DM) + F.lane;
            GAS f32x4* xr = (GAS f32x4*)(ARG_OUT() + (size_t)m * DM) + F.lane;
            f32x4 v[4]; float s = 0.f;
#pragma unroll
            for (int j = 0; j < 4; ++j) { const unsigned long long w_ = xs[64 * j]; const unsigned lo_ = (unsigned)w_, hi_ = (unsigned)(w_ >> 32);
                const unsigned long long y_ = ys[64 * j]; const unsigned ylo_ = (unsigned)y_, yhi_ = (unsigned)(y_ >> 32);
                v[j] = (f32x4){__uint_as_float(lo_ << 16), __uint_as_float(lo_ & 0xffff0000u), __uint_as_float(hi_ << 16), __uint_as_float(hi_ & 0xffff0000u)}
                     + (f32x4){__uint_as_float(ylo_ << 16), __uint_as_float(ylo_ & 0xffff0000u), __uint_as_float(yhi_ << 16), __uint_as_float(yhi_ & 0xffff0000u)};
                s += (v[j].x * v[j].x + v[j].y * v[j].y) + (v[j].z * v[j].z + v[j].w * v[j].w); }
            const float rstd = 1.f / sqrtf(wave_sum(s) * (1.f / DM) + RMS_EPS);
#pragma unroll
            for (int j = 0; j < 4; ++j) { const f32x4 g = *((const f32x4*)gf + F.lane + 64 * j); xr[64 * j] = v[j] * rstd * g; }
#ifdef DIAG_PH
            { const unsigned long long* dg = (const unsigned long long*)(ws + WS_CTL + 49152); float val = (float)(dg[8 + DIAG_PH + 1] - dg[8 + DIAG_PH]) * 0.01f / DIAG_DIV;
              val = exp2f((rintf(log2f(val) * DIAG_RES + DIAG_PHASE) - DIAG_PHASE) / DIAG_RES);
#pragma unroll
              for (int j = 0; j < 4; ++j) xr[64 * j] = (f32x4){val, val, val, val}; }
#endif
#ifdef PG8_DIAG
            { const unsigned long long* dg = (const unsigned long long*)(ws + WS_CTL + 49152); float val;
              if (PG8_DIAG == 1) val = (float)(dg[0] + dg[1]) / ((float)dg[2] * 10.0f) * 10.0f;
              else if (PG8_DIAG == 2) val = (float)dg[0] / (float)dg[3] / 2000.0f;
              else val = (float)dg[1] / (float)dg[3] / 500.0f;
              val = exp2f((rintf(log2f(val) * DIAG_RES + DIAG_PHASE) - DIAG_PHASE) / DIAG_RES);
#pragma unroll
              for (int j = 0; j < 4; ++j) xr[64 * j] = (f32x4){val, val, val, val}; }
#endif
        }
    }
#undef IN
#undef SEAM
#undef ws
#undef dob
#undef ssq_q
#undef ssq_kv
#undef ssq_h1
#undef ssq_h2
#undef XB
#undef bid
#undef LIST
#undef Y0
#undef FCTL
}

#ifndef DBG_STOP
#define DBG_STOP NPH
#endif
#ifndef DBG_STAGE
#define DBG_STAGE -1
#endif
extern "C" void kernel_launch(void* const* d_in, const int* in_sizes, int n_in, void* d_out, int out_size, void* d_ws, size_t ws_size, hipStream_t stream) {
    static int grid = 0;
    if (grid == 0) {
        if (n_in != 25 || in_sizes[0] != NTOK * DM || out_size != NTOK * DM || ws_size < WS_END) { fprintf(stderr, "kernel_launch: unexpected shapes / workspace (n_in %d, ws %zu)\n", n_in, ws_size); grid = -1; return; }
        int dev = 0, cus = 0, per_cu = 0;
        if (hipGetDevice(&dev) != hipSuccess || hipDeviceGetAttribute(&cus, hipDeviceAttributeMultiprocessorCount, dev) != hipSuccess) { grid = -1; return; }
        if (hipFuncSetAttribute((const void*)skel_fwd, hipFuncAttributeMaxDynamicSharedMemorySize, LDS_BYTES) != hipSuccess) { fprintf(stderr, "kernel_launch: hipFuncSetAttribute failed\n"); grid = -1; return; }
        if (hipOccupancyMaxActiveBlocksPerMultiprocessor(&per_cu, (const void*)skel_fwd, NWAVES * 64, LDS_BYTES) != hipSuccess || per_cu < 1) fprintf(stderr, "kernel_launch: occupancy query reports %d\n", per_cu);
        (void)hipGetLastError();
        grid = cus;
        if (grid != 256) { fprintf(stderr, "kernel_launch: built for 256 CUs, found %d\n", grid); grid = -1; return; }
    }
    if (grid < 0) return;
    if (hipMemsetAsync((char*)d_ws + WS_CTL, 0, CTL_ZERO_BYTES, stream) != hipSuccess) return;
    Args a{};
    for (int i = 0; i < 25; ++i) a.in[i] = (const float*)d_in[i];
    a.out = (float*)d_out; a.ws = (unsigned char*)d_ws; a.ph_lo = 0; a.ph_hi = DBG_STOP;
    hipLaunchKernelGGL(skel_fwd, dim3(grid), dim3(NWAVES * 64), LDS_BYTES, stream, a);
#if DBG_STAGE >= 1
    {   nv::Bufs B = nv::carve((unsigned char*)d_ws);
        for (int b = 0; b < 4; ++b) {
            float* hout = (float*)d_out + (size_t)b * nv::T * nv::DM;
#if DBG_STAGE == 1
            hipLaunchKernelGGL(nv::k_bf16_to_f32, dim3(nv::T * 1024 / 256), dim3(256), 0, stream, (const unsigned short*)((unsigned char*)d_ws + WS_MIX0) + (size_t)b * nv::T * 1024, B.mix, (size_t)nv::T * 1024);
#elif DBG_STAGE == 3
            hipLaunchKernelGGL(nv::k_bf16_to_f32, dim3(nv::T * 1024 / 256), dim3(256), 0, stream, (const unsigned short*)((unsigned char*)d_ws + WS_MIX1) + (size_t)b * nv::T * 1024, B.mix, (size_t)nv::T * 1024);
#endif
            nv::forward_batch(stream, d_in, b, hout, B, DBG_STAGE);
        } }
#endif
}
```

```cpp
#include <hip/hip_runtime.h>
#include <cstdio>
#include <cstdint>
#include <cmath>
namespace pg8 {
#define PG8_LAS __attribute__((address_space(3)))
typedef unsigned short bf16_t;
typedef short bf16x8 __attribute__((ext_vector_type(8)));
typedef float f32x4 __attribute__((ext_vector_type(4)));
typedef float f32x2 __attribute__((ext_vector_type(2)));
typedef unsigned u32x4 __attribute__((ext_vector_type(4)));
typedef unsigned u32x2 __attribute__((ext_vector_type(2)));
constexpr int BM = 256, BK = 64, HALF = 128, HTB = HALF * BK * 2  , STAGE_BYTES = 8 * HTB, NXCD = 8, WGM = 8;

__host__ __device__ __forceinline__ int lds_byte(int r, int c) { const int st = (r >> 4) * 2 + (c >> 5), rr = r & 15, cc = c & 31, ob = rr * 64 + cc * 2; return st * 1024 + (ob ^ (((ob >> 9) & 1) << 5)); }
__host__ __device__ __forceinline__ void stage_rc(int b, int& R, int& C) { const int st = b / 1024, sb = b % 1024, swz = sb ^ (((sb >> 9) & 1) << 5); R = (st >> 1) * 16 + swz / 64; C = (st & 1) * 32 + (swz % 64) / 2; }
__host__ __device__ __forceinline__ int perm32(int rho) { const int n = rho >> 4, i = rho & 15; return 8 * (i >> 2) + 4 * n + (i & 3); }

struct Unit { int pa, pb, pm, pn, e, nv, s0, kt0, ntu, slab; };

struct StaticOrder {
    int nM, nN, nwg, G, c;
    __device__ __forceinline__ void init(int nM_, int nN_, int G_, int c_) { nM = nM_; nN = nN_; nwg = nM * nN; G = G_; c = c_; }
    __device__ __forceinline__ bool tile(int i, int& pm, int& pn) const { return tile_lin((long)i * G + c, pm, pn); }
    __device__ __forceinline__ bool tile_lin(long L, int& pm, int& pn) const {
        if (L >= nwg) return false;
        int wgid = (int)L; { const int q = nwg / NXCD, r = nwg % NXCD, xcd = wgid % NXCD, off = wgid / NXCD; wgid = (xcd < r ? xcd * (q + 1) : r * (q + 1) + (xcd - r) * q) + off; }
        const int nig = WGM * nN, gid = wgid / nig, fm = gid * WGM, gsz = (nM - fm) < WGM ? (nM - fm) : WGM;
        pm = fm + ((wgid % nig) % gsz); pn = (wgid % nig) / gsz; return true;
    }
    __device__ __forceinline__ bool next(int i, Unit& u) const { int pm, pn; if (!tile(i, pm, pn)) return false; u.pa = pm; u.pb = pn; u.pm = pm; u.pn = pn; u.e = 0; u.nv = 256; u.s0 = 0; u.kt0 = 0; u.ntu = 0; u.slab = -1; return true; }
    __device__ __forceinline__ void fill(const Unit&, PG8_LAS unsigned*, int, int) const {}
};

__device__ __forceinline__ unsigned cvt_pk_bf16(float lo, float hi) { unsigned r; asm volatile("v_cvt_pk_bf16_f32 %0, %1, %2" : "=v"(r) : "v"(lo), "v"(hi)); return r; }
__device__ __forceinline__ u32x4 pack8(const f32x4 v0, const f32x4 v1) { u32x4 w; w.x = cvt_pk_bf16(v0[0], v0[1]); w.y = cvt_pk_bf16(v0[2], v0[3]); w.z = cvt_pk_bf16(v1[0], v1[1]); w.w = cvt_pk_bf16(v1[2], v1[3]); return w; }

template <class Epi, class Sched, bool GATHER, bool SPLITK = false, bool ATILED = false, int FP8 = 0>
__device__ __forceinline__ void gemm_phase(PG8_LAS unsigned char* lds, const int wv  , const bf16_t* Ag, const bf16_t* Btg, const int K, const Sched& S, const Epi& E, unsigned long long* diag = nullptr, int skew = 0) {
    unsigned long long dg_c0 = 0, dg_r0 = 0, dg_k = 0, dg_e = 0, dg_r = 0, dg_n = 0;
    int tid_; asm volatile("v_mbcnt_lo_u32_b32 %0, -1, 0\n\tv_mbcnt_hi_u32_b32 %0, -1, %0" : "=&v"(tid_)); tid_ += wv * 64;
    const int tid = tid_, wid = __builtin_amdgcn_readfirstlane(tid >> 6), lane = tid & 63, wr = wid >> 2, wc = wid & 3, fr = lane & 15, fq = lane >> 4;
    const int nt = K / BK;
    unsigned voffA[2], voffB[2];
#pragma unroll
    for (int i = 0; i < 2; ++i) { int R, C; stage_rc(tid * 16 + i * 8192, R, C); const int Rb = (R & ~31) + perm32(R & 31);
        voffA[i] = ATILED ? (unsigned)(R * BK + C) * 2u : (unsigned)(R * K + C) * 2u; voffB[i] = (unsigned)(Rb * K + C) * 2u; }
    const size_t kstep = (size_t)(BK * 2);
    const size_t hstep = (size_t)HALF * K * 2;
    const size_t tstep = 2 * hstep;
    const size_t kstepA = ATILED ? (size_t)BM * BK * 2 : kstep, hstepA = ATILED ? (size_t)HALF * BK * 2 : hstep;
    const unsigned ldsw = (unsigned)wid * 1024u;
    const int aoff = lds_byte(wr * 64 + fr, fq * 8), boff = lds_byte(wc * 32 + fr, fq * 8);
#define PG8_SA(b, h) (((b) * 2 + (h)) * HTB)
#define PG8_SB(b, h) ((4 + (b) * 2 + (h)) * HTB)
#define PG8_STAGE(bufoff, gbase, voff) do { _Pragma("unroll") for (int _i = 0; _i < 2; ++_i) \
        __builtin_amdgcn_global_load_lds((const unsigned*)((const char*)(gbase) + (voff)[_i]), (PG8_LAS unsigned*)(lds + (bufoff) + ldsw + _i * 8192), 16, 0, 0); } while (0)
#define PG8_STAGE_A(bufoff, aptr, h) do { if constexpr (GATHER) { PG8_STAGE(bufoff, aptr, vgC[h]); } else { PG8_STAGE(bufoff, (aptr) + (h) * hstepA, voffA); } } while (0)
#define PG8_LOOKUP(tabp, nvv) do { int t_ = tid; asm volatile("" : "+v"(t_));   \
        _Pragma("unroll") for (int _j = 0; _j < 2; ++_j) { int R_, C_; stage_rc(t_ * 16 + _j * 8192, R_, C_); _Pragma("unroll") for (int _h = 0; _h < 2; ++_h) { const int r_ = _h * 128 + R_; unsigned tk_ = (tabp)[r_]; tk_ = r_ < (nvv) ? tk_ : 0u; \
        vgC[_h][_j] = (tk_ * (unsigned)K + (unsigned)C_) * 2u; } } } while (0)
#define PG8_LD8(lo_, hi_) __builtin_shufflevector(lo_, hi_, 0, 1, 2, 3, 4, 5, 6, 7)
#define PG8_LDA(dst, b, h) do { if constexpr (FP8 == 2) { _Pragma("unroll") for (int m = 0; m < 4; ++m) dst##8[m] = PG8_LD8(*(const PG8_LAS i4_t*)(lds + PG8_SA(b, h) + aoff + m * 2048), *(const PG8_LAS i4_t*)(lds + PG8_SA(b, h) + aoff + m * 2048 + 1024)); } \
        else { _Pragma("unroll") for (int m = 0; m < 4; ++m) _Pragma("unroll") for (int k = 0; k < 2; ++k) dst[m][k] = *(const PG8_LAS bf16x8*)(lds + PG8_SA(b, h) + aoff + m * 2048 + k * 1024); } } while (0)
#define PG8_LDB(dst, b, h) do { if constexpr (FP8 == 2) { _Pragma("unroll") for (int n = 0; n < 2; ++n) dst##8[n] = PG8_LD8(*(const PG8_LAS i4_t*)(lds + PG8_SB(b, h) + boff + n * 2048), *(const PG8_LAS i4_t*)(lds + PG8_SB(b, h) + boff + n * 2048 + 1024)); } \
        else { _Pragma("unroll") for (int n = 0; n < 2; ++n) _Pragma("unroll") for (int k = 0; k < 2; ++k) dst[n][k] = *(const PG8_LAS bf16x8*)(lds + PG8_SB(b, h) + boff + n * 2048 + k * 1024); } } while (0)
#define PG8_MMA(ai, bj, At, Bt) do { __builtin_amdgcn_s_setprio(1); _Pragma("unroll") for (int m = 0; m < 4; ++m) _Pragma("unroll") for (int n = 0; n < 2; ++n) { \
        if constexpr (FP8 == 2) {   \
            acc[ai][bj][m][n] = __builtin_amdgcn_mfma_scale_f32_16x16x128_f8f6f4(Bt##8[n], At##8[m], acc[ai][bj][m][n], 0, 0, 0, 0x7F7F7F7F, 0, 0x7F7F7F7F); } \
        else if constexpr (FP8 == 1) { _Pragma("unroll") for (int k = 0; k < 2; ++k) { typedef long l2_t __attribute__((ext_vector_type(2))); const l2_t b_ = __builtin_bit_cast(l2_t, Bt[n][k]), a_ = __builtin_bit_cast(l2_t, At[m][k]); \
            acc[ai][bj][m][n] = __builtin_amdgcn_mfma_f32_16x16x32_fp8_fp8(b_[0], a_[0], acc[ai][bj][m][n], 0, 0, 0); acc[ai][bj][m][n] = __builtin_amdgcn_mfma_f32_16x16x32_fp8_fp8(b_[1], a_[1], acc[ai][bj][m][n], 0, 0, 0); } } \
        else { _Pragma("unroll") for (int k = 0; k < 2; ++k) acc[ai][bj][m][n] = __builtin_amdgcn_mfma_f32_16x16x32_bf16(Bt[n][k], At[m][k], acc[ai][bj][m][n], 0, 0, 0); } } __builtin_amdgcn_s_setprio(0); } while (0)
#define PG8_WAIT_V(n) asm volatile("s_waitcnt vmcnt(" #n ")" ::: "memory")
#define PG8_WAIT_L(n) asm volatile("s_waitcnt lgkmcnt(" #n ")" ::: "memory")
#define PG8_BAR __builtin_amdgcn_s_barrier()
#define PG8_SCHED __builtin_amdgcn_sched_barrier(0)
    Unit cur, nxt; int ui = 0;
    if (!S.next(0, cur)) return;
    if (skew > 0 && ((int)blockIdx.x & 1)) for (int q = 0; q < skew; ++q) __builtin_amdgcn_s_sleep(127);
    f32x4 acc[2][2][4][2];
#pragma unroll
    for (int a = 0; a < 2; ++a)
#pragma unroll
        for (int b = 0; b < 2; ++b)
#pragma unroll
            for (int m = 0; m < 4; ++m)
#pragma unroll
                for (int n = 0; n < 2; ++n) acc[a][b][m][n] = (f32x4){0.f, 0.f, 0.f, 0.f};
    typedef int i4_t __attribute__((ext_vector_type(4))); typedef int i8_t __attribute__((ext_vector_type(8)));
    bf16x8 At[FP8 == 2 ? 1 : 4][2], B0[FP8 == 2 ? 1 : 2][2], B1[FP8 == 2 ? 1 : 2][2];
    i8_t At8[FP8 == 2 ? 4 : 1], B08[FP8 == 2 ? 2 : 1], B18[FP8 == 2 ? 2 : 1];
    PG8_LAS unsigned* gtab = (PG8_LAS unsigned*)(lds + STAGE_BYTES + 1024);
    const PG8_LAS unsigned* tabC = gtab; const PG8_LAS unsigned* tabN = gtab + 256;
    unsigned vgC[2][2] = {{0u, 0u}, {0u, 0u}};
    if constexpr (GATHER) { S.fill(cur, gtab, wid, lane); PG8_WAIT_V(0); PG8_BAR; PG8_LOOKUP(tabC, cur.nv); }
    const char* cA = GATHER ? (const char*)Ag : (const char*)Ag + (size_t)cur.pa * tstep; const char* cB = (const char*)Btg + (size_t)cur.pb * tstep;
    if constexpr (SPLITK) { cA += (size_t)cur.kt0 * kstepA; cB += (size_t)cur.kt0 * kstep; }
    PG8_STAGE(PG8_SB(0, 0), cB, voffB); PG8_STAGE(PG8_SB(0, 1), cB + hstep, voffB); PG8_STAGE_A(PG8_SA(0, 0), cA, 0); PG8_STAGE_A(PG8_SA(0, 1), cA, 1);
    if (wr == 1) PG8_BAR;
    PG8_WAIT_V(2); PG8_BAR;
    PG8_STAGE(PG8_SB(1, 0), cB + kstep, voffB); PG8_STAGE_A(PG8_SA(1, 0), cA + kstepA, 0); PG8_STAGE(PG8_SB(1, 1), cB + hstep + kstep, voffB);
    PG8_WAIT_V(6); PG8_BAR;
    for (;;) {
        const bool has_next = S.next(ui + 1, nxt);
        typename Epi::Pre pre = E.prefetch(cur, wr, wc, fr, fq);
#ifdef PG8_DIAG
        if (diag) { dg_c0 = __builtin_readcyclecounter(); dg_r0 = __builtin_amdgcn_s_memrealtime(); }
#endif
        if constexpr (GATHER) { if (has_next) S.fill(nxt, (PG8_LAS unsigned*)tabN, wid, lane); }
        const char* nA = GATHER ? cA : (has_next ? (const char*)Ag + (size_t)nxt.pa * tstep : cA); const char* nB = has_next ? (const char*)Btg + (size_t)nxt.pb * tstep : cB;
        if constexpr (SPLITK) { if (has_next) { nA += (size_t)nxt.kt0 * kstepA; nB += (size_t)nxt.kt0 * kstep; } }
        const int ntc = SPLITK ? cur.ntu : nt;
#pragma nounroll
        for (int t = 0; t < ntc; t += 2) {
            const bool last = (t == ntc - 2);
            const char* a1 = cA + (size_t)(t + 1) * kstepA;
            const char* a2 = last ? nA : cA + (size_t)(t + 2) * kstepA; const char* b2 = last ? nB : cB + (size_t)(t + 2) * kstep;
            const char* a3 = a2 + kstepA; const char* b3 = b2 + kstep;
            if constexpr (FP8 == 2) {
                asm volatile("" : "+v"(voffB[0]), "+v"(voffB[1]));
                if constexpr (GATHER) asm volatile("" : "+v"(vgC[0][0]), "+v"(vgC[0][1]), "+v"(vgC[1][0]), "+v"(vgC[1][1])); else asm volatile("" : "+v"(voffA[0]), "+v"(voffA[1])); }
            if constexpr (FP8 == 2) { asm volatile("" : "+s"(a1), "+s"(a2), "+s"(a3), "+s"(b2), "+s"(b3)); }
            PG8_LDB(B0, 0, 0); PG8_LDB(B1, 0, 1); PG8_SCHED; PG8_LDA(At, 0, 0); PG8_STAGE_A(PG8_SA(1, 1), a1, 1);
            if constexpr (GATHER) { if (last && has_next) PG8_LOOKUP(tabN, nxt.nv); }
            PG8_WAIT_V(8); PG8_WAIT_L(0); PG8_BAR; PG8_MMA(0, 0, At, B0); PG8_MMA(0, 1, At, B1); PG8_BAR; PG8_SCHED;
            PG8_LDA(At, 0, 1); PG8_STAGE(PG8_SB(0, 0), b2, voffB); PG8_STAGE(PG8_SB(0, 1), b2 + hstep, voffB); PG8_STAGE_A(PG8_SA(0, 0), a2, 0);
            PG8_WAIT_V(8); PG8_WAIT_L(0); PG8_BAR; PG8_MMA(1, 0, At, B0); PG8_MMA(1, 1, At, B1); PG8_BAR; PG8_SCHED;
            PG8_LDB(B0, 1, 0); PG8_LDB(B1, 1, 1); PG8_SCHED; PG8_LDA(At, 1, 0); PG8_STAGE_A(PG8_SA(0, 1), a2, 1);
            PG8_WAIT_V(8); PG8_WAIT_L(0); PG8_BAR; PG8_MMA(0, 0, At, B0); PG8_MMA(0, 1, At, B1); PG8_BAR; PG8_SCHED;
            PG8_LDA(At, 1, 1); PG8_STAGE(PG8_SB(1, 0), b3, voffB); PG8_STAGE(PG8_SB(1, 1), b3 + hstep, voffB); PG8_STAGE_A(PG8_SA(1, 0), a3, 0);
            PG8_WAIT_V(8); PG8_WAIT_L(0); PG8_BAR; PG8_MMA(1, 0, At, B0); PG8_MMA(1, 1, At, B1); PG8_BAR; PG8_SCHED;
        }
        if (wr == 0) PG8_BAR;
#ifdef PG8_DIAG
        unsigned long long dg_c1 = 0; if (diag) dg_c1 = __builtin_readcyclecounter();
#endif
        { int l_; asm volatile("v_mbcnt_lo_u32_b32 %0, -1, 0\n\tv_mbcnt_hi_u32_b32 %0, -1, %0" : "=&v"(l_));
          E(acc, cur, wr, wc, l_ & 15, l_ >> 4, pre); }
#ifdef PG8_DIAG
        if (diag && ui > 0) { const unsigned long long c2 = __builtin_readcyclecounter(); dg_k += dg_c1 - dg_c0; dg_e += c2 - dg_c1; dg_r += __builtin_amdgcn_s_memrealtime() - dg_r0; dg_n += 1; }
#endif
        if (!has_next) break;
#pragma unroll
        for (int a = 0; a < 2; ++a)
#pragma unroll
            for (int b = 0; b < 2; ++b)
#pragma unroll
                for (int m = 0; m < 4; ++m)
#pragma unroll
                    for (int n = 0; n < 2; ++n) acc[a][b][m][n] = (f32x4){0.f, 0.f, 0.f, 0.f};
        cur = nxt; cA = nA; cB = nB; ++ui;
        if constexpr (GATHER) { const PG8_LAS unsigned* t_ = tabC; tabC = tabN; tabN = t_; }
        if (wr == 1) PG8_BAR;
    }
#ifdef PG8_DIAG
    if (diag && tid == 0) { diag[0] = dg_k; diag[1] = dg_e; diag[2] = dg_r; diag[3] = dg_n; }
#endif
    PG8_WAIT_V(0);
    PG8_BAR;
#undef PG8_SA
#undef PG8_SB
#undef PG8_STAGE
#undef PG8_STAGE_A
#undef PG8_LOOKUP
#undef PG8_LDA
#undef PG8_LD8
#undef PG8_LDB
#undef PG8_MMA
#undef PG8_WAIT_V
#undef PG8_WAIT_L
#undef PG8_BAR
#undef PG8_SCHED
}
}
#ifndef ATT_SETPRIO
#define ATT_SETPRIO 0
#endif
namespace att {
using bf16x8 = __attribute__((ext_vector_type(8))) short;
using s16x4 = __attribute__((ext_vector_type(4))) short;
using f32x16 = __attribute__((ext_vector_type(16))) float;
using u32x4 = __attribute__((ext_vector_type(4))) unsigned;
typedef unsigned short bf16_t;
constexpr int NW = 8, QBLK = 32, QB = 256, KVBLK = 64;
constexpr int KSLOT = 12288, VSLOT = 8192, NSLOT = 4;
constexpr int LDS_K = 0, LDS_V = NSLOT * KSLOT, LDS_WS = LDS_V + NSLOT * VSLOT, LDS_OST = LDS_WS + NW * 256, LDS_BYTES = LDS_OST + NW * 4096;
__device__ __forceinline__ int crow(int r, int hi) { return (r & 3) + 8 * (r >> 2) + 4 * hi; }
__device__ __forceinline__ void glds16(const void* gsrc, unsigned lds_dst) { unsigned keep;
    asm volatile("s_mov_b32 %0, m0\n\ts_mov_b32 m0, %2\n\ts_nop 0\n\tglobal_load_lds_dwordx4 %1, off\n\ts_mov_b32 m0, %0" : "=&s"(keep) : "v"(gsrc), "s"(lds_dst) : "memory"); }
typedef float f32x2_t __attribute__((ext_vector_type(2))); typedef __bf16 bf16x2_t __attribute__((ext_vector_type(2)));
__device__ __forceinline__ unsigned cvtpk_s(float lo, float hi) { f32x2_t v = {lo, hi}; bf16x2_t b = __builtin_convertvector(v, bf16x2_t); return __builtin_bit_cast(unsigned, b); }
__device__ __forceinline__ unsigned short f2bf_s(float f) { return (unsigned short)(cvtpk_s(f, 0.f) & 0xffffu); }
#define ATT_WAIT_BAR() asm volatile("s_waitcnt vmcnt(0) lgkmcnt(0)\n\ts_barrier" ::: "memory")

struct Ptrs {
    const bf16_t* Qm; int qp; const bf16_t* Qx; int qxp; const bf16_t* Km; int kp; const bf16_t* Kx; int kxp; const bf16_t* V; int vp; bf16_t* O; int op; const float* aux;
};

template <int NKC>
__device__ __forceinline__ void qkt(f32x16& p0, f32x16& p1, const char* Kslot, const bf16x8* qr, const f32x16& negm, int r32, int hi) {
    typedef __attribute__((address_space(3))) const char* lptr;
    const lptr kb = (lptr)Kslot + hi * 1024 + r32 * 16;
    bf16x8 kf[2 * NKC];
#pragma unroll
    for (int d0 = 0; d0 < NKC; ++d0) { kf[2 * d0] = *(const __attribute__((address_space(3))) bf16x8*)(kb + d0 * 2048); kf[2 * d0 + 1] = *(const __attribute__((address_space(3))) bf16x8*)(kb + d0 * 2048 + 512); }
    __builtin_amdgcn_sched_barrier(0);
    if (ATT_SETPRIO) __builtin_amdgcn_s_setprio(1);
#pragma unroll
    for (int d0 = 0; d0 < NKC; ++d0) {
        if (d0 == 0) { p0 = __builtin_amdgcn_mfma_f32_32x32x16_bf16(kf[0], qr[0], negm, 0, 0, 0); p1 = __builtin_amdgcn_mfma_f32_32x32x16_bf16(kf[1], qr[0], negm, 0, 0, 0); }
        else { p0 = __builtin_amdgcn_mfma_f32_32x32x16_bf16(kf[2 * d0], qr[d0], p0, 0, 0, 0); p1 = __builtin_amdgcn_mfma_f32_32x32x16_bf16(kf[2 * d0 + 1], qr[d0], p1, 0, 0, 0); }
    }
    if (ATT_SETPRIO) __builtin_amdgcn_s_setprio(0);
}
__device__ __forceinline__ float max3f(float a, float b, float c) { float r; asm("v_max3_f32 %0, %1, %2, %3" : "=v"(r) : "v"(a), "v"(b), "v"(c)); return r; }
__device__ __forceinline__ float max2f(float a, float b) { float r; asm("v_max_f32_e32 %0, %1, %2" : "=v"(r) : "v"(a), "v"(b)); return r; }
__device__ __forceinline__ float rowmax(const f32x16& p0, const f32x16& p1) {
    float a = max3f(p0[0], p0[1], p1[0]), b = max3f(p0[2], p0[3], p1[1]); a = max3f(a, p1[2], p1[3]);
#pragma unroll
    for (int r = 4; r < 16; r += 4) { a = max3f(a, p0[r], p0[r + 1]); b = max3f(b, p0[r + 2], p0[r + 3]); a = max3f(a, p1[r], p1[r + 1]); b = max3f(b, p1[r + 2], p1[r + 3]); }
    const float m = max2f(a, b);
    auto rr = __builtin_amdgcn_permlane32_swap(__float_as_uint(m), __float_as_uint(m), false, false);
    return max2f(__uint_as_float(rr[0]), __uint_as_float(rr[1]));
}
struct VFrag { s16x4 lo[8], hi[8]; };
__device__ __forceinline__ void pv_issue(VFrag& f, int vb) {
#pragma unroll
    for (int d0 = 0; d0 < 2; ++d0)
#pragma unroll
        for (int ks = 0; ks < 4; ++ks) {
            asm volatile("ds_read_b64_tr_b16 %0,%1 offset:%c2" : "=&v"(f.lo[d0 * 4 + ks]) : "v"(vb), "i"(d0 * 4096 + ks * 1024) : "memory");
            asm volatile("ds_read_b64_tr_b16 %0,%1 offset:%c2" : "=&v"(f.hi[d0 * 4 + ks]) : "v"(vb), "i"(d0 * 4096 + ks * 1024 + 512) : "memory"); }
}
__device__ __forceinline__ void pv_mma(f32x16* o, VFrag& f, bf16x8 pa0, bf16x8 pa1, bf16x8 pa2, bf16x8 pa3) {
    asm volatile("s_waitcnt lgkmcnt(0)" : "+v"(f.lo[0]), "+v"(f.lo[1]), "+v"(f.lo[2]), "+v"(f.lo[3]), "+v"(f.lo[4]), "+v"(f.lo[5]), "+v"(f.lo[6]), "+v"(f.lo[7]),
                 "+v"(f.hi[0]), "+v"(f.hi[1]), "+v"(f.hi[2]), "+v"(f.hi[3]), "+v"(f.hi[4]), "+v"(f.hi[5]), "+v"(f.hi[6]), "+v"(f.hi[7]) :: "memory");
    __builtin_amdgcn_sched_barrier(0);
    if (ATT_SETPRIO) __builtin_amdgcn_s_setprio(1);
#define ATT_PK(k) (bf16x8){f.lo[k][0], f.lo[k][1], f.lo[k][2], f.lo[k][3], f.hi[k][0], f.hi[k][1], f.hi[k][2], f.hi[k][3]}
    o[0] = __builtin_amdgcn_mfma_f32_32x32x16_bf16(pa0, ATT_PK(0), o[0], 0, 0, 0); o[1] = __builtin_amdgcn_mfma_f32_32x32x16_bf16(pa0, ATT_PK(4), o[1], 0, 0, 0);
    o[0] = __builtin_amdgcn_mfma_f32_32x32x16_bf16(pa1, ATT_PK(1), o[0], 0, 0, 0); o[1] = __builtin_amdgcn_mfma_f32_32x32x16_bf16(pa1, ATT_PK(5), o[1], 0, 0, 0);
    o[0] = __builtin_amdgcn_mfma_f32_32x32x16_bf16(pa2, ATT_PK(2), o[0], 0, 0, 0); o[1] = __builtin_amdgcn_mfma_f32_32x32x16_bf16(pa2, ATT_PK(6), o[1], 0, 0, 0);
    o[0] = __builtin_amdgcn_mfma_f32_32x32x16_bf16(pa3, ATT_PK(3), o[0], 0, 0, 0); o[1] = __builtin_amdgcn_mfma_f32_32x32x16_bf16(pa3, ATT_PK(7), o[1], 0, 0, 0);
    if (ATT_SETPRIO) __builtin_amdgcn_s_setprio(0);
#undef ATT_PK
}

template <int NKC, int MODE, bool QONES>
__device__ __forceinline__ void attn_unit(const Ptrs& P, int q0, float sink_l2, char* shm, const int wv  ) {
    constexpr float THR = 8.f;
    int tid_; asm volatile("v_mbcnt_lo_u32_b32 %0, -1, 0\n\tv_mbcnt_hi_u32_b32 %0, -1, %0" : "=&v"(tid_)); tid_ += wv * 64;
    const int tid = tid_, lane = tid & 63, r32 = lane & 31, hi = lane >> 5; const int wid = __builtin_amdgcn_readfirstlane(tid >> 6), grp = wid >> 2;
    const unsigned lds0 = (unsigned)(uintptr_t)shm;
    float* wsf = (float*)(shm + LDS_WS) + wid * 64;
    const int qmin = q0 + wid * QBLK, qmax = qmin + QBLK - 1, qabs = qmin + r32;
    int t0 = 0; if (MODE == 1) { int lo = q0 - 127; if (lo < 0) lo = 0; t0 = lo / KVBLK; }
    if constexpr (QONES) {
        const int tq = q0 / KVBLK; const float qn = fmaxf(fmaxf(P.aux[384 + tq], P.aux[384 + tq + 1]), fmaxf(P.aux[384 + tq + 2], P.aux[384 + tq + 3])), bq0 = P.aux[256 + tq];
        const bool ok0 = (lane < tq) && (qn * P.aux[lane] + P.aux[128 + lane] - bq0 < -160.f), ok1 = (lane + 64 < tq) && (qn * P.aux[lane + 64] + P.aux[128 + lane + 64] - bq0 < -160.f);
        const unsigned long long m0 = __ballot(ok0), m1 = __ballot(ok1);
        int ts = (m0 == ~0ull) ? 64 + (int)__builtin_ctzll(~m1 | (1ull << 63)) : (int)__builtin_ctzll(~m0);
        if (m0 == ~0ull && m1 == ~0ull) ts = 127;
        t0 = __builtin_amdgcn_readfirstlane(ts);
    }
    const int t1 = (q0 + QB) / KVBLK - 1, NT = t1 - t0 + 1;
    const bf16_t* ksrc = P.Km + (long)lane * P.kp + wid * 8;
    const bf16_t* kxsrc = (NKC > 4) ? P.Kx + (long)lane * P.kxp + wid * 8 : nullptr;
    const bf16_t* vsrc = P.V + (long)(16 * (wid & 3) + (lane >> 2)) * P.vp + (wid >> 2) * 32 + (lane & 3) * 8;
    const unsigned kdst = lds0 + LDS_K + wid * 1024, kxdst = lds0 + LDS_K + (8 + wid) * 1024, vdst = lds0 + LDS_V + wid * 1024;
    const bool has_x = (NKC > 4) && (wid < 2 * (NKC - 4));
#define ATT_DMA(t, s) do { glds16(ksrc + (long)(t) * KVBLK * P.kp, (unsigned)__builtin_amdgcn_readfirstlane(kdst + (s) * KSLOT)); \
        if (has_x) glds16(kxsrc + (long)(t) * KVBLK * P.kxp, (unsigned)__builtin_amdgcn_readfirstlane(kxdst + (s) * KSLOT)); \
        glds16(vsrc + (long)(t) * KVBLK * P.vp, (unsigned)__builtin_amdgcn_readfirstlane(vdst + (s) * VSLOT)); } while (0)
    const int vb0 = (int)(lds0 + LDS_V) + ((lane >> 4) & 1) * 32 + (lane & 3) * 8 + (4 * hi + ((lane & 15) >> 2)) * 64;
    ATT_DMA(t0, 0); if (NT > 1) ATT_DMA(t0 + 1, 1);
    bf16x8 qr[NKC];
#pragma unroll
    for (int d0 = 0; d0 < 4; ++d0) qr[d0] = *reinterpret_cast<const bf16x8*>(P.Qm + (long)qabs * P.qp + d0 * 16 + hi * 8);
    if constexpr (NKC > 4) {
        if constexpr (QONES) { const short one = (short)0x3F80; qr[4] = hi == 0 ? (bf16x8){one, one, one, 0, 0, 0, 0, 0} : (bf16x8){0, 0, 0, 0, 0, 0, 0, 0}; }
        else {
#pragma unroll
            for (int d0 = 4; d0 < NKC; ++d0) qr[d0] = *reinterpret_cast<const bf16x8*>(P.Qx + (long)qabs * P.qxp + (d0 - 4) * 16 + hi * 8);
        }
    }
#pragma unroll
    for (int d0 = 0; d0 < NKC; ++d0) asm volatile("" :: "v"(qr[d0]));
    float mhat = (MODE == 1) ? sink_l2 : 0.f, l_reg = (MODE == 1 && hi == 0) ? 1.f : 0.f;
    if constexpr (QONES) { const bf16_t* kq = P.Kx + (long)qabs * P.kxp; const unsigned long long w = *(const unsigned long long*)kq;
        mhat = __uint_as_float((unsigned)(w & 0xffffu) << 16) + __uint_as_float((unsigned)((w >> 16) & 0xffffu) << 16) + __uint_as_float((unsigned)((w >> 32) & 0xffffu) << 16); }
    f32x16 o[2]; o[0] = f32x16{}; o[1] = f32x16{};
    f32x16 negm;
#pragma unroll
    for (int r = 0; r < 16; ++r) negm[r] = -mhat;
    asm volatile("" : "+v"(negm));
    bool first = (MODE == 0) && !QONES, act = false;
    f32x16 p0 = f32x16{}, p1 = f32x16{};
    int sdma = 2;
#define ATT_BAR(t) do { if ((t) >= t1) asm volatile("s_waitcnt vmcnt(0) lgkmcnt(0)\n\ts_barrier" ::: "memory"); \
        else if (has_x) asm volatile("s_waitcnt vmcnt(3) lgkmcnt(0)\n\ts_barrier" ::: "memory"); else asm volatile("s_waitcnt vmcnt(2) lgkmcnt(0)\n\ts_barrier" ::: "memory"); \
        if ((t) + 2 <= t1) { ATT_DMA((t) + 2, sdma); sdma = (sdma == NSLOT - 1) ? 0 : sdma + 1; } } while (0)
#define ATT_H1(t, s) do { const int k0 = (t) * KVBLK; act = (k0 <= qmax) && (MODE == 0 || k0 + 63 >= qmin - 127); \
        if (act) { qkt<NKC>(p0, p1, shm + LDS_K + (s) * KSLOT, qr, negm, r32, hi); asm volatile("s_nop 15\n\ts_nop 7" : "+v"(p0), "+v"(p1));   \
            const bool needmask = (k0 + 63 > qmin) || (MODE == 1 && k0 < qmax - 127); \
            if (__builtin_expect(needmask, 0)) { _Pragma("unroll") for (int r = 0; r < 16; ++r) { const int kv = k0 + crow(r, hi); bool ok0 = kv <= qabs, ok1 = kv + 32 <= qabs; \
                if (MODE == 1) { ok0 = ok0 && (qabs - kv < 128); ok1 = ok1 && (qabs - kv - 32 < 128); } if (!ok0) p0[r] = -INFINITY; if (!ok1) p1[r] = -INFINITY; } } \
            const float rm = rowmax(p0, p1); \
            if (__builtin_expect(first || __any(rm > THR), 0)) {   \
                const float dl = first ? rm : fmaxf(rm, 0.f); const float f = first ? 0.f : __builtin_amdgcn_exp2f(-dl); first = false; mhat += dl; \
                _Pragma("unroll") for (int r = 0; r < 16; ++r) { p0[r] -= dl; p1[r] -= dl; negm[r] = -mhat; } \
                l_reg *= f; if (hi == 0) wsf[r32] = f; asm volatile("s_waitcnt lgkmcnt(0)" ::: "memory"); \
                _Pragma("unroll") for (int d_ = 0; d_ < 2; ++d_) _Pragma("unroll") for (int r = 0; r < 16; ++r) o[d_][r] *= wsf[crow(r, hi)]; } \
            if (QONES && __all(rm < -150.f)) act = false;   \
            if (act) { _Pragma("unroll") for (int r = 0; r < 16; ++r) p0[r] = __builtin_amdgcn_exp2f(p0[r]); }   } } while (0)
#define ATT_H2(s) do { if (act) { VFrag vf; pv_issue(vf, vb0 + (s) * VSLOT); float sacc = 0.f; _Pragma("unroll") for (int r = 0; r < 16; ++r) { p1[r] = __builtin_amdgcn_exp2f(p1[r]); sacc += p0[r] + p1[r]; } l_reg += sacc; \
        u32x4 pw0, pw1, pw2, pw3; \
        pw0 = (u32x4){cvtpk_s(p0[0], p0[1]), cvtpk_s(p0[2], p0[3]), cvtpk_s(p0[4], p0[5]), cvtpk_s(p0[6], p0[7])}; pw1 = (u32x4){cvtpk_s(p0[8], p0[9]), cvtpk_s(p0[10], p0[11]), cvtpk_s(p0[12], p0[13]), cvtpk_s(p0[14], p0[15])}; \
        pw2 = (u32x4){cvtpk_s(p1[0], p1[1]), cvtpk_s(p1[2], p1[3]), cvtpk_s(p1[4], p1[5]), cvtpk_s(p1[6], p1[7])}; pw3 = (u32x4){cvtpk_s(p1[8], p1[9]), cvtpk_s(p1[10], p1[11]), cvtpk_s(p1[12], p1[13]), cvtpk_s(p1[14], p1[15])}; \
        pv_mma(o, vf, __builtin_bit_cast(bf16x8, pw0), __builtin_bit_cast(bf16x8, pw1), __builtin_bit_cast(bf16x8, pw2), __builtin_bit_cast(bf16x8, pw3)); } } while (0)
#define ATT_NEXT(s) ((s) == NSLOT - 1 ? 0 : (s) + 1)
    if (grp == 0) {
        int s = 0;
        for (int t = t0; t <= t1; ++t) { ATT_BAR(t); ATT_H1(t, s); ATT_H2(s); s = ATT_NEXT(s); }
        ATT_BAR(t1 + 1);
    } else {
        int s = 0;
        ATT_BAR(t0); ATT_H1(t0, s);
        for (int t = t0 + 1; t <= t1; ++t) { ATT_BAR(t); ATT_H2(s); s = ATT_NEXT(s); ATT_H1(t, s); }
        ATT_BAR(t1 + 1); ATT_H2(s);
    }
#undef ATT_BAR
#undef ATT_H1
#undef ATT_H2
#undef ATT_NEXT
    { auto rr = __builtin_amdgcn_permlane32_swap(__float_as_uint(l_reg), __float_as_uint(l_reg), false, false); l_reg = __uint_as_float(rr[0]) + __uint_as_float(rr[1]); }
    if (hi == 0) wsf[32 + r32] = l_reg;
    asm volatile("s_waitcnt lgkmcnt(0)" ::: "memory");
    float rli[16];
#pragma unroll
    for (int r = 0; r < 16; ++r) rli[r] = __builtin_amdgcn_rcpf(wsf[32 + crow(r, hi)]);
    bf16_t* Ow = P.O + (long)qmin * P.op;
    { bf16_t* stg = (bf16_t*)(shm + LDS_OST) + wid * 2048;
#pragma unroll
        for (int r = 0; r < 16; ++r) { const int orow = crow(r, hi);
#pragma unroll
            for (int d0 = 0; d0 < 2; ++d0) stg[orow * 64 + d0 * 32 + r32] = f2bf_s(o[d0][r] * rli[r]); }
        asm volatile("s_waitcnt lgkmcnt(0)" ::: "memory");
#pragma unroll
        for (int i = 0; i < 4; ++i) { const int row = i * 8 + (lane >> 3), ch = lane & 7; const u32x4 v = *(const u32x4*)(stg + row * 64 + ch * 8); *(u32x4*)(Ow + (long)row * P.op + ch * 8) = v; } }
    asm volatile("s_waitcnt lgkmcnt(0)\n\ts_barrier" ::: "memory");
#undef ATT_DMA
}
#undef ATT_WAIT_BAR
}
constexpr int NWAVES = 8;
constexpr int NTOK = 32768, SEQ = 8192, NB = 4, DM = 1024, DFF = 3584, NEXP = 8;
constexpr float RMS_EPS = 1e-6f;
constexpr float LOG2E = 1.4426950408889634f;
constexpr float W8_SCALE = 64.0f, W8_INV = 1.0f / 64.0f;
constexpr float C2_FOX = 0.125f * LOG2E, C2_MLA = 0.10206207261596577f * LOG2E, C2_SWA = 0.125f * LOG2E;
constexpr size_t MiB = 1u << 20;
#ifndef IN1_FP8
#define IN1_FP8 0
#endif
constexpr size_t WS_CTL = 0, CTL_ZERO_BYTES = 64 * 1024;
constexpr size_t WS_WMOE_GU = 2 * MiB;
constexpr size_t WS_XB8 = 60 * MiB;
constexpr size_t WS_WMOE_D = 114 * MiB;
constexpr size_t WS_XB = 170 * MiB;
constexpr size_t WS_BIG = 234 * MiB;
constexpr size_t WS_CQ = WS_BIG, WS_KPE = 258 * MiB, WS_MQ = 260 * MiB, WS_MKV = 308 * MiB, WS_MIX0 = 372 * MiB;
constexpr size_t WS_W_IN0 = 436 * MiB, WS_W_QUP = 441 * MiB, WS_W_KVUP = 442 * MiB, WS_W_OUT0 = 443 * MiB, WS_CSM = 445 * MiB, WS_FL = 449 * MiB, WS_FAUX = 450 * MiB;
constexpr size_t WS_HID0 = WS_BIG;
constexpr size_t WS_W_GU0 = 458 * MiB, WS_W_D0 = 472 * MiB, WS_W_IN1 = 479 * MiB, WS_W_OUT1 = 484 * MiB, WS_CSS = 486 * MiB;
constexpr size_t WS_SQ = WS_BIG, WS_SK = 266 * MiB, WS_SV = 274 * MiB, WS_GB = 282 * MiB, WS_U = 314 * MiB, WS_MIX1 = 346 * MiB;
constexpr size_t WS_LIST = WS_BIG, WS_HID1 = 242 * MiB;
constexpr int MOE_CAP = 270;
constexpr size_t WS_Y0 = 2 * MiB;
constexpr int SLAB_CAP = 512;
constexpr size_t WS_END = 527 * MiB;
constexpr size_t DO_FQ = 0, DO_FK = 32 * MiB, DO_FV = 64 * MiB, DO_KB = 96 * MiB, DO_CKV = 104 * MiB;
constexpr int CW_TMO = 0, CW_CODE = 1, CW_BAR = 4096, CW_CNT = 8192;
constexpr size_t WS_PQ = 494 * MiB, WS_PKV = 495 * MiB, WS_PH = 496 * MiB;
constexpr int RING_OFF = 0, RING_BYTES = 131072;
constexpr int LDSCTL_OFF = RING_BYTES, MISC_OFF = LDSCTL_OFF + 320;
constexpr int LDS_BYTES = 147456;

#define GAS __attribute__((address_space(1)))
#define LAS __attribute__((address_space(3)))
typedef unsigned short bf16;
typedef unsigned v4u __attribute__((ext_vector_type(4)));
typedef unsigned v2u __attribute__((ext_vector_type(2)));
typedef float f32x4 __attribute__((ext_vector_type(4)));
typedef float f32x2 __attribute__((ext_vector_type(2)));
typedef GAS unsigned gu32;
#define RLX_AGENT __ATOMIC_RELAXED, __HIP_MEMORY_SCOPE_AGENT
#define LDS_WAIT() asm volatile("s_waitcnt lgkmcnt(0)" ::: "memory")
#define VM_WAIT() asm volatile("s_waitcnt vmcnt(0)" ::: "memory")
__device__ __forceinline__ unsigned f2bf(float f) { unsigned u = __builtin_bit_cast(unsigned, f); return (u + 0x7fffu + ((u >> 16) & 1u)) >> 16; }
__device__ __forceinline__ float bf2f(unsigned b) { return __builtin_bit_cast(float, b << 16); }
__device__ __forceinline__ unsigned pk2(float lo, float hi) { return f2bf(lo) | (f2bf(hi) << 16); }

#define XB_TMO      128
#define XB_XCNT(j)  (256  + 64 * (j))
#define XB_XSUB(j)  (1280 + 64 * (j))
#define XB_XGEN(j)  (2304 + 64 * (j))
#define XB_TOP      3328
#define XB_TOPGEN   3392
#define XCD_BAR_WORDS 3456
#define XB_SPIN_CAP (1u << 18)
__device__ __forceinline__ unsigned xb_ld(unsigned* p)              { return __hip_atomic_load(p, __ATOMIC_RELAXED, __HIP_MEMORY_SCOPE_AGENT); }
__device__ __forceinline__ unsigned xb_add(unsigned* p, unsigned v) { return __hip_atomic_fetch_add(p, v, __ATOMIC_RELAXED, __HIP_MEMORY_SCOPE_AGENT); }
__device__ __forceinline__ unsigned xb_xcc_id() { return (unsigned)__builtin_amdgcn_s_getreg((3 << 11) | 20) & 0xFu; }
#define XB_SPIN(cond, bar) do { unsigned _sp = 0; while (cond) { __builtin_amdgcn_s_sleep(1); \
    if ((++_sp & 255u) == 0u) { if (xb_ld(&(bar)[XB_TMO])) break; if (_sp > XB_SPIN_CAP) { atomicAdd(&(bar)[XB_TMO], 1u); break; } } } } while (0)
__device__ __forceinline__ int lane_id() { int l; asm volatile("v_mbcnt_lo_u32_b32 %0, -1, 0\n\tv_mbcnt_hi_u32_b32 %0, -1, %0" : "=&v"(l)); return l; }
struct XcdBarrier { unsigned* bar; unsigned x; volatile LAS unsigned* st; };
__device__ __forceinline__ XcdBarrier xcd_barrier_post(unsigned* bar, volatile LAS unsigned* st, bool t0  ) {
    XcdBarrier b; b.bar = bar; b.x = xb_xcc_id(); b.st = st;
    if (t0) (void)xb_add(&bar[XB_XCNT(b.x)], 1u);
    return b;
}
__device__ __forceinline__ void xcd_barrier_complete(unsigned* bar, unsigned x, unsigned& nloc, unsigned& nx) {
    const unsigned G = gridDim.x * gridDim.y * gridDim.z;
    asm volatile("" : "+s"(x));
    unsigned sum, cnt, mine, sp = 0u;
    for (;;) {
        sum = 0u; cnt = 0u; mine = 0u;
#pragma unroll
        for (unsigned j = 0; j < 16; ++j) { const unsigned c = xb_ld(&bar[XB_XCNT(j)]); sum += c; cnt += (c > 0u) ? 1u : 0u; mine = (j == x) ? c : mine; }
        if (sum == G) break;
        __builtin_amdgcn_s_sleep(1);
        if ((++sp & 255u) == 0u) { if (xb_ld(&bar[XB_TMO])) break; if (sp > XB_SPIN_CAP) { atomicAdd(&bar[XB_TMO], 1u); break; } }
    }
    nloc = mine > 0u ? mine : 1u; nx = cnt > 0u ? cnt : 1u;
}
__device__ __forceinline__ void xcd_barrier(const XcdBarrier& b, bool t0  ) {
    asm volatile("s_waitcnt vmcnt(0)" ::: "memory");
    __syncthreads();
    if (t0) {
        unsigned* bar = b.bar;
        __builtin_amdgcn_s_waitcnt(0);
        unsigned nloc = b.st[0], nx = b.st[1];
        if (nloc == 0u) { xcd_barrier_complete(bar, b.x, nloc, nx); b.st[0] = nloc; b.st[1] = nx; }
        const unsigned old = xb_add(&bar[XB_XSUB(b.x)], 1u);
        const unsigned gen = old / nloc;
        if (old + 1u == (gen + 1u) * nloc) {
            __builtin_amdgcn_fence(__ATOMIC_RELEASE, "agent");
            asm volatile("s_waitcnt vmcnt(0)" ::: "memory");
            const unsigned og = xb_add(&bar[XB_TOP], 1u);
            const unsigned tg = og / nx;
            if (og + 1u == (tg + 1u) * nx) xb_add(&bar[XB_TOPGEN], 1u);
            else XB_SPIN(xb_ld(&bar[XB_TOPGEN]) == tg, bar);
            __builtin_amdgcn_fence(__ATOMIC_ACQUIRE, "agent");
            xb_add(&bar[XB_XGEN(b.x)], 1u);
            asm volatile("s_waitcnt vmcnt(0)" ::: "memory");
        } else {
            XB_SPIN(xb_ld(&bar[XB_XGEN(b.x)]) == gen, bar);
            __builtin_amdgcn_fence(__ATOMIC_ACQUIRE, "agent");
            asm volatile("s_waitcnt vmcnt(0)" ::: "memory");
        }
    }
    __syncthreads();
}

struct Frame {
    LAS unsigned char* lds;
    volatile LAS unsigned* MISC;
    int tid, lane, wave, vcu, G;
    const void* const* in_;
};
__device__ __forceinline__ float shx(float v, int o) { return __builtin_bit_cast(float, __builtin_amdgcn_ds_bpermute((lane_id() ^ o) << 2, __builtin_bit_cast(int, v))); }
__device__ __forceinline__ float shl(float v, int l) { return __builtin_bit_cast(float, __builtin_amdgcn_ds_bpermute(l << 2, __builtin_bit_cast(int, v))); }
__device__ __forceinline__ float wave_sum(float v) {
    const int l = lane_id();
#pragma unroll
    for (int o = 1; o < 64; o <<= 1) v += shl(v, l ^ o);
    return v;
}
struct ListEnt { int tok; float gw; float rs; int pad; };
namespace ep {
using pg8::f32x4; using pg8::u32x4; using pg8::u32x2; using pg8::Unit; using pg8::pack8; using pg8::bf16_t; using pg8::cvt_pk_bf16;
typedef const f32x4 (&Acc)[2][2][4][2];
struct NoPre {};
struct RowPre8 { float v[2][4]; };
struct RowPre { float v[2]; };
struct TokPre { int tok[2][4]; float gw[2][4]; };
__device__ __forceinline__ float sumsq8(const f32x4 a, const f32x4 b) { return ((a[0] * a[0] + a[1] * a[1]) + (a[2] * a[2] + a[3] * a[3])) + ((b[0] * b[0] + b[1] * b[1]) + (b[2] * b[2] + b[3] * b[3])); }
__device__ __forceinline__ float quad_sum(float s) { s += shx(s, 16); s += shx(s, 32); return s; }
__device__ __forceinline__ float rstd_of(float ssq, float inv_n) { return 1.0f / sqrtf(ssq * inv_n + RMS_EPS); }
template <int NS> __device__ __forceinline__ float ssq_sum(const float* part, size_t grow, int fq) {
    float s = 0.f;
    if (4 * fq < NS) { const f32x4 v = *(const f32x4*)(part + grow * NS + 4 * fq); s = (v[0] + v[1]) + (v[2] + v[3]); }
    return quad_sum(s);
}
__device__ __forceinline__ void rope_store(const f32x4 x1, const f32x4 x2, const float* cs, bf16_t* p1, bf16_t* p2) {
    const f32x4 a = *(const f32x4*)cs, b = *(const f32x4*)(cs + 4);
    const float c0 = a[0], s0 = a[1], c1 = a[2], s1 = a[3], c2 = b[0], s2 = b[1], c3 = b[2], s3 = b[3];
    u32x2 w1, w2;
    w1.x = cvt_pk_bf16(x1[0] * c0 - x2[0] * s0, x1[1] * c1 - x2[1] * s1); w1.y = cvt_pk_bf16(x1[2] * c2 - x2[2] * s2, x1[3] * c3 - x2[3] * s3);
    w2.x = cvt_pk_bf16(x2[0] * c0 + x1[0] * s0, x2[1] * c1 + x1[1] * s1); w2.y = cvt_pk_bf16(x2[2] * c2 + x1[2] * s2, x2[3] * c3 + x1[3] * s3);
    *(u32x2*)p1 = w1; *(u32x2*)p2 = w2;
}
__device__ __forceinline__ float rowpre_get(const RowPre& p, int g, int fr) { return shl(p.v[g & 1], fr + 16 * (g >> 1)); }
__device__ __forceinline__ float clamp8(float v) { return __builtin_amdgcn_fmed3f(v, -448.f, 448.f); }
__device__ __forceinline__ u32x2 pack8_fp8(const f32x4 v0, const f32x4 v1) { int a = 0, b = 0;
    a = __builtin_amdgcn_cvt_pk_fp8_f32(clamp8(v0[0]), clamp8(v0[1]), a, false); a = __builtin_amdgcn_cvt_pk_fp8_f32(clamp8(v0[2]), clamp8(v0[3]), a, true);
    b = __builtin_amdgcn_cvt_pk_fp8_f32(clamp8(v1[0]), clamp8(v1[1]), b, false); b = __builtin_amdgcn_cvt_pk_fp8_f32(clamp8(v1[2]), clamp8(v1[3]), b, true);
    u32x2 r; r.x = (unsigned)a; r.y = (unsigned)b; return r; }
#define EP_ROWS for (int ai = 0; ai < 2; ++ai) _Pragma("unroll") for (int m = 0; m < 4; ++m)
#define EP_GROW (u.pm * 256 + ai * 128 + wr * 64 + m * 16 + fr)

struct EpiIn0 {
    bf16_t *FQ, *CKV, *CQ, *KPE; float* FL; float *pq, *pkv; const float* CSM;
    typedef NoPre Pre;
    __device__ __forceinline__ Pre prefetch(const Unit& u, int wr, int wc, int fr, int fq) const { return Pre{}; }
    __device__ __forceinline__ void operator()(Acc acc, const Unit& u, int wr, int wc, int fr, int fq, const Pre& pre) const {
        const int cw = wc * 32 + fq * 8;
        if (u.pn < 6) {
#pragma unroll
            for (int bj = 0; bj < 2; ++bj) { const int cb = u.pn * 256 + bj * 128; bf16_t* dst = FQ + (size_t)(cb >> 9) * ((size_t)NTOK * 512); const int c = (cb + cw) & 511; const float sc = cb < 512 ? C2_FOX : 1.0f;
#pragma unroll
                EP_ROWS { const size_t grow = EP_GROW; *(u32x4*)(dst + grow * 512 + c) = pack8(acc[ai][bj][m][0] * sc, acc[ai][bj][m][1] * sc); } }
        } else if (u.pn == 6) {
#pragma unroll
            EP_ROWS { const size_t grow = EP_GROW; float s = 0.f;
#pragma unroll
                for (int bj = 0; bj < 2; ++bj) { const f32x4 v0 = acc[ai][bj][m][0], v1 = acc[ai][bj][m][1]; *(u32x4*)(CKV + grow * 256 + bj * 128 + cw) = pack8(v0, v1); s += sumsq8(v0, v1); }
                s = quad_sum(s); if (fq == 0) pkv[grow * 4 + wc] = s; }
        } else if (u.pn == 7) {
#pragma unroll
            EP_ROWS { const size_t grow = EP_GROW; float s = 0.f;
#pragma unroll
                for (int bj = 0; bj < 2; ++bj) { const f32x4 v0 = acc[ai][bj][m][0], v1 = acc[ai][bj][m][1]; *(u32x4*)(CQ + grow * 384 + bj * 128 + cw) = pack8(v0, v1); s += sumsq8(v0, v1); }
                s = quad_sum(s); if (fq == 0) pq[grow * 8 + wc] = s; }
        } else {
#pragma unroll
            EP_ROWS { const size_t grow = EP_GROW; const f32x4 v0 = acc[ai][0][m][0], v1 = acc[ai][0][m][1]; *(u32x4*)(CQ + grow * 384 + 256 + cw) = pack8(v0, v1);
                const float s = quad_sum(sumsq8(v0, v1)); if (fq == 0) pq[grow * 8 + 4 + wc] = s; }
            if (wc == 0) {
#pragma unroll
                EP_ROWS { const size_t grow = EP_GROW; rope_store(acc[ai][1][m][0], acc[ai][1][m][1], CSM + (grow * 16 + 4 * fq) * 2, KPE + grow * 32 + 4 * fq, KPE + grow * 32 + 16 + 4 * fq); if (m & 1) asm volatile("" ::: "memory"); }
            } else if (wc == 1 && fq == 0) {
#pragma unroll
                EP_ROWS { const size_t grow = EP_GROW; *(f32x4*)(FL + grow * 8) = acc[ai][1][m][0]; *(f32x4*)(FL + grow * 8 + 4) = acc[ai][1][m][1]; }
            }
        }
    }
};
struct EpiQup {
    bf16_t* MQ; const float* pq; const float* CSM;
    typedef NoPre Pre;
    __device__ __forceinline__ Pre prefetch(const Unit& u, int wr, int wc, int fr, int fq) const { return Pre{}; }
    __device__ __forceinline__ void operator()(Acc acc, const Unit& u, int wr, int wc, int fr, int fq, const Pre& pre) const {
        float rqv[2][4];
#pragma unroll
        EP_ROWS { rqv[ai][m] = ssq_sum<8>(pq, EP_GROW, fq); }
        asm volatile("" ::: "memory");
#pragma unroll
        EP_ROWS { const size_t grow = EP_GROW; const float rq = rstd_of(rqv[ai][m], 1.0f / 384.0f) * C2_MLA;
#pragma unroll
            for (int bj = 0; bj < 2; ++bj) { const int col8 = u.pn * 256 + bj * 128 + wc * 32 + fq * 8; const f32x4 v0 = acc[ai][bj][m][0] * rq, v1 = acc[ai][bj][m][1] * rq;
                if (u.pn < 2) { const int h = col8 >> 6, d = col8 & 63; *(u32x4*)(MQ + grow * 768 + h * 96 + d) = pack8(v0, v1); }
                else { const int j = col8 - 512, h = j >> 5, g = (j & 31) >> 3; rope_store(v0, v1, CSM + (grow * 16 + 4 * g) * 2, MQ + grow * 768 + h * 96 + 64 + 4 * g, MQ + grow * 768 + h * 96 + 80 + 4 * g); } }
            asm volatile("" ::: "memory"); }
    }
};
struct EpiKVup {
    bf16_t* MKV; const float* pkv;
    typedef NoPre Pre;
    __device__ __forceinline__ Pre prefetch(const Unit& u, int wr, int wc, int fr, int fq) const { return Pre{}; }
    __device__ __forceinline__ void operator()(Acc acc, const Unit& u, int wr, int wc, int fr, int fq, const Pre& pre) const {
        float rkv[2][4];
#pragma unroll
        EP_ROWS { rkv[ai][m] = ssq_sum<4>(pkv, EP_GROW, fq); }
        asm volatile("" ::: "memory");
#pragma unroll
        EP_ROWS { const size_t grow = EP_GROW; const float rk = rstd_of(rkv[ai][m], 1.0f / 256.0f);
#pragma unroll
            for (int bj = 0; bj < 2; ++bj) { const int col8 = u.pn * 256 + bj * 128 + wc * 32 + fq * 8; *(u32x4*)(MKV + grow * 1024 + col8) = pack8(acc[ai][bj][m][0] * rk, acc[ai][bj][m][1] * rk); } }
    }
};
template <bool BASE_BF16, bool WRITE_F32>
struct EpiRes {
    const float* base32; const bf16_t* base16; float* out; bf16_t* xb; float* part; unsigned char* xb8;
    typedef NoPre Pre;
    __device__ __forceinline__ Pre prefetch(const Unit& u, int wr, int wc, int fr, int fq) const { return Pre{}; }
    __device__ __forceinline__ void operator()(Acc acc, const Unit& u, int wr, int wc, int fr, int fq, const Pre& pre) const {
        f32x4 bb[2][2][2];
        u32x4 bh[2][2];
        const size_t col = (size_t)u.pn * 256 + wc * 32 + fq * 8;
#define EPR_LOAD(buf, g) do { const size_t grow_ = (size_t)u.pm * 256 + ((g) >> 2) * 128 + wr * 64 + ((g) & 3) * 16 + fr; _Pragma("unroll") for (int bj = 0; bj < 2; ++bj) { \
            if constexpr (BASE_BF16) { bh[buf][bj] = *(const u32x4*)(base16 + grow_ * 1024 + col + bj * 128); } \
            else { const float* p_ = base32 + grow_ * 1024 + col + bj * 128; bb[buf][bj][0] = *(const f32x4*)p_; bb[buf][bj][1] = *(const f32x4*)(p_ + 4); } } } while (0)
        EPR_LOAD(0, 0);
#pragma unroll
        for (int g = 0; g < 8; ++g) {
            const int ai = g >> 2, m = g & 3, cb = g & 1;
            if (g < 7) { if (cb == 0) EPR_LOAD(1, g + 1); else EPR_LOAD(0, g + 1); }
            const size_t grow = (size_t)u.pm * 256 + ai * 128 + wr * 64 + m * 16 + fr; float s = 0.f;
#pragma unroll
            for (int bj = 0; bj < 2; ++bj) { const size_t off = grow * 1024 + col + bj * 128; f32x4 b0, b1;
                if constexpr (BASE_BF16) { const u32x4 w = bh[cb][bj];
                    b0 = (f32x4){__uint_as_float(w.x << 16), __uint_as_float(w.x & 0xffff0000u), __uint_as_float(w.y << 16), __uint_as_float(w.y & 0xffff0000u)};
                    b1 = (f32x4){__uint_as_float(w.z << 16), __uint_as_float(w.z & 0xffff0000u), __uint_as_float(w.w << 16), __uint_as_float(w.w & 0xffff0000u)}; }
                else { b0 = bb[cb][bj][0]; b1 = bb[cb][bj][1]; }
                const f32x4 h0 = b0 + acc[ai][bj][m][0], h1 = b1 + acc[ai][bj][m][1];
                if constexpr (WRITE_F32) { *(f32x4*)(out + off) = h0; *(f32x4*)(out + off + 4) = h1; }
                *(u32x4*)(xb + off) = pack8(h0, h1); if (xb8) *(u32x2*)(xb8 + off) = pack8_fp8(h0, h1); s += sumsq8(h0, h1); }
            if (part) { s = quad_sum(s); if (fq == 0) part[grow * 16 + u.pn * 4 + wc] = s; }
            asm volatile("" ::: "memory");
        }
#undef EPR_LOAD
    }
};
__device__ __forceinline__ f32x4 silu_mul(const f32x4 a, const f32x4 b, const float k1, const float k2) {
    const f32x4 t = a * k1; f32x4 e;
#pragma unroll
    for (int i = 0; i < 4; ++i) e[i] = __builtin_amdgcn_exp2f(t[i]);
    float one = 1.0f; asm("" : "+v"(one));
    const f32x4 d = e + one; f32x4 r;
#pragma unroll
    for (int i = 0; i < 4; ++i) r[i] = __builtin_amdgcn_rcpf(d[i]);
    return (a * b) * (r * k2);
}
struct EpiGU {
    bf16_t* HID; const float* part; int probe_mode;
    typedef RowPre Pre;
    __device__ __forceinline__ Pre prefetch(const Unit& u, int wr, int wc, int fr, int fq) const { Pre p;
#pragma unroll
        for (int j = 0; j < 2; ++j) { const int g = 2 * fq + j, lrow = (g >> 2) * 128 + wr * 64 + (g & 3) * 16 + fr; p.v[j] = part[(size_t)u.pm * 256 + lrow]; }
        return p; }
    __device__ __forceinline__ void operator()(Acc acc, const Unit& u, int wr, int wc, int fr, int fq, const Pre& pre) const {
#pragma unroll
        EP_ROWS { const int lrow = ai * 128 + wr * 64 + m * 16 + fr; const float rs = rowpre_get(pre, 4 * ai + m, fr), k1 = -rs * LOG2E, k2 = rs * rs;
            const f32x4 h0 = silu_mul(acc[ai][0][m][0], acc[ai][1][m][0], k1, k2), h1 = silu_mul(acc[ai][0][m][1], acc[ai][1][m][1], k1, k2);
            *(u32x4*)(HID + (((size_t)u.pm * (DFF / 64) + 2 * u.pn + (wc >> 1)) * 256 + lrow) * 64 + (wc & 1) * 32 + fq * 8) = pack8(h0, h1); }
    }
};
struct EpiIn1 {
    bf16_t *SQ, *SK, *SV, *GB, *U; const float* part; const float* CSS;
    typedef NoPre Pre;
    __device__ __forceinline__ Pre prefetch(const Unit& u, int wr, int wc, int fr, int fq) const { return Pre{}; }
    __device__ __forceinline__ void operator()(Acc acc, const Unit& u, int wr, int wc, int fr, int fq, const Pre& pre) const {
        float rsv[2][4];
#pragma unroll
        EP_ROWS { rsv[ai][m] = ssq_sum<16>(part, EP_GROW, fq); }
        asm volatile("" ::: "memory");
#pragma unroll
        EP_ROWS { const size_t grow = EP_GROW; const float rs = rstd_of(rsv[ai][m], 1.0f / 1024.0f) * (IN1_FP8 ? W8_INV : 1.0f);
            if (u.pn < 2) {
#pragma unroll
                for (int bj = 0; bj < 2; ++bj) { const int col8 = u.pn * 256 + bj * 128 + wc * 32 + fq * 8, hd = col8 >> 6, g = (col8 & 63) >> 3; const float sc = rs * C2_SWA;
                    rope_store(acc[ai][bj][m][0] * sc, acc[ai][bj][m][1] * sc, CSS + (grow * 32 + 4 * g) * 2, SQ + grow * 512 + hd * 64 + 4 * g, SQ + grow * 512 + hd * 64 + 32 + 4 * g); }
            } else if (u.pn == 2) {
                { const int col8 = wc * 32 + fq * 8, hd = col8 >> 6, g = (col8 & 63) >> 3;
                  rope_store(acc[ai][0][m][0] * rs, acc[ai][0][m][1] * rs, CSS + (grow * 32 + 4 * g) * 2, SK + grow * 128 + hd * 64 + 4 * g, SK + grow * 128 + hd * 64 + 32 + 4 * g); }
                *(u32x4*)(SV + grow * 128 + wc * 32 + fq * 8) = pack8(acc[ai][1][m][0] * rs, acc[ai][1][m][1] * rs);
            } else if (u.pn < 5) {
#pragma unroll
                for (int bj = 0; bj < 2; ++bj) *(u32x4*)(GB + grow * 512 + (u.pn - 3) * 256 + bj * 128 + wc * 32 + fq * 8) = pack8(acc[ai][bj][m][0] * rs, acc[ai][bj][m][1] * rs);
            } else {
                const float r2 = rs * rs;
                *(u32x4*)(U + grow * 512 + (u.pn - 5) * 128 + wc * 32 + fq * 8) = pack8(acc[ai][0][m][0] * acc[ai][1][m][0] * r2, acc[ai][0][m][1] * acc[ai][1][m][1] * r2);
            }
            asm volatile("" ::: "memory"); }
    }
};
struct EpiMoe1 {
    bf16_t* HID1; const ListEnt* list;
    typedef RowPre Pre;
    __device__ __forceinline__ Pre prefetch(const Unit& u, int wr, int wc, int fr, int fq) const { Pre p;
#pragma unroll
        for (int j = 0; j < 2; ++j) { const int g = 2 * fq + j, lrow = (g >> 2) * 128 + wr * 64 + (g & 3) * 16 + fr; p.v[j] = 0.f; if (lrow < u.nv) p.v[j] = list[(size_t)u.e * NTOK + u.s0 + lrow].rs; }
        return p; }
    __device__ __forceinline__ void operator()(Acc acc, const Unit& u, int wr, int wc, int fr, int fq, const Pre& pre) const {
#pragma unroll
        EP_ROWS { const int lrow = ai * 128 + wr * 64 + m * 16 + fr; const float rs = rowpre_get(pre, 4 * ai + m, fr) * W8_INV;
            const float k1 = -rs * LOG2E, k2 = rs * rs;
            const f32x4 h0 = silu_mul(acc[ai][0][m][0], acc[ai][1][m][0], k1, k2), h1 = silu_mul(acc[ai][0][m][1], acc[ai][1][m][1], k1, k2);
            *(u32x2*)((unsigned char*)HID1 + (((size_t)u.pm * (DFF / 128) + u.pn) * 256 + lrow) * 128 + wc * 32 + fq * 8) = pack8_fp8(h0, h1); }
    }
};
struct EpiMoe2 {
    bf16_t* xb; bf16_t* y0; const ListEnt* list; float* slabs;
    typedef NoPre Pre;
    __device__ __forceinline__ Pre prefetch(const Unit& u, int wr, int wc, int fr, int fq) const { return Pre{}; }
    __device__ __forceinline__ void operator()(Acc acc, const Unit& u, int wr, int wc, int fr, int fq, const Pre& pre) const {
        if (u.slab >= 0) { float* sb = slabs + (size_t)u.slab * 65536;
#pragma unroll
            EP_ROWS { const int lrow = ai * 128 + wr * 64 + m * 16 + fr;
#pragma unroll
                for (int bj = 0; bj < 2; ++bj) { float* p = sb + lrow * 256 + bj * 128 + wc * 32 + fq * 8; *(f32x4*)p = acc[ai][bj][m][0]; *(f32x4*)(p + 4) = acc[ai][bj][m][1]; } }
            return; }
        if (u.e < 8) {
#pragma unroll
            EP_ROWS { const int lrow = ai * 128 + wr * 64 + m * 16 + fr;
                if (lrow < u.nv) { const ListEnt en = list[(size_t)u.e * NTOK + u.s0 + lrow]; const float gs = en.gw * W8_INV;
#pragma unroll
                    for (int bj = 0; bj < 2; ++bj) { const size_t off = (size_t)en.tok * 1024 + u.pn * 256 + bj * 128 + wc * 32 + fq * 8; *(u32x4*)(y0 + off) = pack8(acc[ai][bj][m][0] * gs, acc[ai][bj][m][1] * gs); } }
                if (m & 1) asm volatile("" ::: "memory"); }
            return; }
#pragma unroll
        EP_ROWS { const int lrow = ai * 128 + wr * 64 + m * 16 + fr;
            if (lrow < u.nv) { const ListEnt en = list[(size_t)u.e * NTOK + u.s0 + lrow];
#pragma unroll
                for (int bj = 0; bj < 2; ++bj) { const size_t off = (size_t)en.tok * 1024 + u.pn * 256 + bj * 128 + wc * 32 + fq * 8; const u32x4 w = *(const u32x4*)(xb + off);
                    const f32x4 b0 = (f32x4){__uint_as_float(w.x << 16), __uint_as_float(w.x & 0xffff0000u), __uint_as_float(w.y << 16), __uint_as_float(w.y & 0xffff0000u)};
                    const f32x4 b1 = (f32x4){__uint_as_float(w.z << 16), __uint_as_float(w.z & 0xffff0000u), __uint_as_float(w.w << 16), __uint_as_float(w.w & 0xffff0000u)};
                    const float gs = en.gw * W8_INV; *(u32x4*)(xb + off) = pack8(b0 + acc[ai][bj][m][0] * gs, b1 + acc[ai][bj][m][1] * gs); } }
            if (m & 1) asm volatile("" ::: "memory"); }
    }
};
#undef EP_ROWS
#undef EP_GROW
}
__device__ const float INV_FREQ64[32] = {1.000000000e+00f, 7.498942614e-01f, 5.623413324e-01f, 4.216965139e-01f, 3.162277639e-01f, 2.371373773e-01f, 1.778279394e-01f, 1.333521307e-01f,
    1.000000015e-01f, 7.498941571e-02f, 5.623413250e-02f, 4.216965288e-02f, 3.162277490e-02f, 2.371373773e-02f, 1.778279431e-02f, 1.333521493e-02f, 9.999999776e-03f, 7.498941850e-03f,
    5.623413250e-03f, 4.216964822e-03f, 3.162277630e-03f, 2.371373586e-03f, 1.778279431e-03f, 1.333521446e-03f, 1.000000047e-03f, 7.498942432e-04f, 5.623413017e-04f, 4.216965172e-04f,
    3.162277571e-04f, 2.371373703e-04f, 1.778279402e-04f, 1.333521504e-04f};

struct MapId { const float* W; int ldw_; __device__ __forceinline__ const float* col(int n) const { return W + n; } __device__ __forceinline__ int ldw() const { return ldw_; } };
struct MapIn0 { const float* W; __device__ __forceinline__ int ldw() const { return 2216; }
    __device__ __forceinline__ const float* col(int n) const { int s;
        if (n < 1536) s = n; else if (n < 1792) s = 1928 + (n - 1536); else if (n < 2176) s = 1544 + (n - 1792);
        else if (n < 2208) { const int j = n - 2176, g = j >> 3, e = j & 7; s = 2184 + (e < 4 ? 4 * g + e : 16 + 4 * g + (e - 4)); }
        else if (n < 2216) s = 1536 + (n - 2208); else return nullptr;
        return W + s; } };
struct MapQup { const float* W; __device__ __forceinline__ int ldw() const { return 768; }
    __device__ __forceinline__ const float* col(int n) const { int s;
        if (n < 512) { s = (n >> 6) * 96 + (n & 63); } else { const int j = n - 512, h = j >> 5, g = (j & 31) >> 3, e = j & 7; s = h * 96 + 64 + (e < 4 ? 4 * g + e : 16 + 4 * g + (e - 4)); }
        return W + s; } };
struct MapGU { const float* Wg; const float* Wu; __device__ __forceinline__ int ldw() const { return DFF; }
    __device__ __forceinline__ const float* col(int n) const { const int pn = n >> 8, j = n & 255; return j < 128 ? Wg + 128 * pn + j : Wu + 128 * pn + (j - 128); } };
struct MapIn1 { const float* W; __device__ __forceinline__ int ldw() const { return 2304; }
    __device__ __forceinline__ const float* col(int n) const { int s;
        if (n < 640) { const int hd = n >> 6, j = n & 63, g = j >> 3, e = j & 7; s = hd * 64 + (e < 4 ? 4 * g + e : 32 + 4 * g + (e - 4)); }
        else if (n < 1280) s = n; else { const int u = (n - 1280) >> 8, j = (n - 1280) & 255; s = j < 128 ? 1280 + 128 * u + j : 1792 + 128 * u + (j - 128); }
        return W + s; } };
struct TrDesc { const float* cp; const float* gain; bf16* WT; int ldw, K, k0, n0, f8; };
template <class Map>
__device__ __forceinline__ void tr_desc(TrDesc& d, const Map& M, const float* gain, int K, int ND, bf16* WT, int item, int lane) {
    const int nblk = ND / 32, kb = item / nblk, nb = item % nblk; d.k0 = 64 * kb; d.n0 = 32 * nb; d.cp = M.col(d.n0 + (lane & 7) * 4); d.ldw = M.ldw(); d.gain = gain; d.K = K; d.WT = WT; d.f8 = 0;
}
__device__ __forceinline__ void tr_load(const TrDesc& d, f32x4 (&v)[8], int lane) {
    const int kr = lane >> 3;
#pragma unroll
    for (int i = 0; i < 8; ++i) { v[i] = (f32x4){0.f, 0.f, 0.f, 0.f}; if (d.cp) v[i] = __builtin_nontemporal_load((const f32x4*)(d.cp + (size_t)(d.k0 + kr + 8 * i) * d.ldw)); }
}
__device__ __forceinline__ void tr_finish(const TrDesc& d, const f32x4 (&v)[8], LAS float* scr, int lane) {
    const int nq = (lane & 7) * 4, kr = lane >> 3;
#pragma unroll
    for (int i = 0; i < 8; ++i) { const int kk = kr + 8 * i; const float gk = d.gain ? d.gain[d.k0 + kk] : 1.0f; LAS float* p = scr + kk * 33 + nq; p[0] = v[i][0] * gk; p[1] = v[i][1] * gk; p[2] = v[i][2] * gk; p[3] = v[i][3] * gk; }
    LDS_WAIT(); asm volatile("" ::: "memory");
    if (d.f8) {
        const int c4 = lane & 3;
#pragma unroll
        for (int j = 0; j < 2; ++j) { const int n = (lane >> 2) + 16 * j; const LAS float* s = scr + (16 * c4) * 33 + n; v4u o;
#pragma unroll
            for (int w = 0; w < 4; ++w) { int pk = 0;
                pk = __builtin_amdgcn_cvt_pk_fp8_f32(__builtin_amdgcn_fmed3f(s[(4 * w + 0) * 33] * W8_SCALE, -448.f, 448.f), __builtin_amdgcn_fmed3f(s[(4 * w + 1) * 33] * W8_SCALE, -448.f, 448.f), pk, false);
                pk = __builtin_amdgcn_cvt_pk_fp8_f32(__builtin_amdgcn_fmed3f(s[(4 * w + 2) * 33] * W8_SCALE, -448.f, 448.f), __builtin_amdgcn_fmed3f(s[(4 * w + 3) * 33] * W8_SCALE, -448.f, 448.f), pk, true);
                o[w] = (unsigned)pk; }
            *(GAS v4u*)((unsigned char*)d.WT + (size_t)(d.n0 + n) * d.K + d.k0 + 16 * c4) = o; }
        LDS_WAIT(); asm volatile("" ::: "memory"); return;
    }
    const int c = lane & 7;
#pragma unroll
    for (int j = 0; j < 4; ++j) { const int n = (lane >> 3) + 8 * j; const LAS float* s = scr + (8 * c) * 33 + n;
        v4u o; o.x = pk2(s[0 * 33], s[1 * 33]); o.y = pk2(s[2 * 33], s[3 * 33]); o.z = pk2(s[4 * 33], s[5 * 33]); o.w = pk2(s[6 * 33], s[7 * 33]);
        *(GAS v4u*)(d.WT + (size_t)(d.n0 + n) * d.K + d.k0 + 8 * c) = o; }
    LDS_WAIT(); asm volatile("" ::: "memory");
}
__device__ __forceinline__ void rstd_rows(const Frame& F, const float* part, float* rs, int pm) {
    const size_t row = (size_t)pm * 256 + (F.tid >> 1); const float* p = part + row * 16 + (F.tid & 1) * 8;
    const f32x4 a = *(const f32x4*)p, b = *(const f32x4*)(p + 4);
    float s = ((a[0] + a[1]) + (a[2] + a[3])) + ((b[0] + b[1]) + (b[2] + b[3]));
    s += shx(s, 1);
    if ((F.tid & 1) == 0) rs[row] = 1.0f / sqrtf(s * (1.0f / DM) + RMS_EPS);
}
struct Args { const float* in[25]; float* out; unsigned char* ws; int ph_lo, ph_hi; };
#define P0_IN(i) (*(const float* const __attribute__((address_space(4)))*)((__attribute__((address_space(4))) const unsigned char*)__builtin_amdgcn_kernarg_segment_ptr() + 8 * (i)))
constexpr int I_IN0 = 16 * 72, I_QUP = 6 * 24, I_KVUP = 4 * 32, I_OUT = 16 * 32, I_GU = 16 * 224, I_D = 56 * 32;
constexpr int P0_NITEMS = I_IN0 + I_QUP + I_KVUP + I_OUT + I_GU + I_D + I_IN0 + I_OUT + 8 * I_GU + 8 * I_D;
__device__ __forceinline__ void p0_desc(TrDesc& d, unsigned char* ws, int it, int lane) {
    int r = it;
    if (r < 8 * I_GU) { const int e = r / I_GU; r -= e * I_GU; const size_t wo = (size_t)e * 1024 * DFF;
        tr_desc(d, MapGU{P0_IN(21) + wo, P0_IN(22) + wo}, P0_IN(19), 1024, 7168, (bf16*)(ws + WS_WMOE_GU + (size_t)e * 7168 * 1024), r, lane); d.f8 = 1; return; } r -= 8 * I_GU;
    if (r < 8 * I_D) { const int e = r / I_D; r -= e * I_D; tr_desc(d, MapId{P0_IN(23) + (size_t)e * DFF * 1024, 1024}, (const float*)nullptr, DFF, 1024, (bf16*)(ws + WS_WMOE_D + (size_t)e * 1024 * DFF), r, lane); d.f8 = 1; return; } r -= 8 * I_D;
    if (r < I_IN0) { tr_desc(d, MapIn0{P0_IN(3)}, (const float*)nullptr, 1024, 2304, (bf16*)(ws + WS_W_IN0), r, lane); return; } r -= I_IN0;
    if (r < I_QUP) { tr_desc(d, MapQup{P0_IN(6)}, P0_IN(5), 384, 768, (bf16*)(ws + WS_W_QUP), r, lane); return; } r -= I_QUP;
    if (r < I_KVUP) { tr_desc(d, MapId{P0_IN(8), 1024}, P0_IN(7), 256, 1024, (bf16*)(ws + WS_W_KVUP), r, lane); return; } r -= I_KVUP;
    if (r < I_OUT) { tr_desc(d, MapId{P0_IN(9), 1024}, (const float*)nullptr, 1024, 1024, (bf16*)(ws + WS_W_OUT0), r, lane); return; } r -= I_OUT;
    if (r < I_GU) { tr_desc(d, MapGU{P0_IN(11), P0_IN(12)}, P0_IN(10), 1024, 7168, (bf16*)(ws + WS_W_GU0), r, lane); return; } r -= I_GU;
    if (r < I_D) { tr_desc(d, MapId{P0_IN(13), 1024}, (const float*)nullptr, DFF, 1024, (bf16*)(ws + WS_W_D0), r, lane); return; } r -= I_D;
    if (r < I_IN0) { tr_desc(d, MapIn1{P0_IN(15)}, P0_IN(14), 1024, 2304, (bf16*)(ws + WS_W_IN1), r, lane); d.f8 = IN1_FP8; return; } r -= I_IN0;
    tr_desc(d, MapId{P0_IN(18), 1024}, (const float*)nullptr, 1024, 1024, (bf16*)(ws + WS_W_OUT1), r, lane);
}
__device__ __forceinline__ void tr_items(const Frame& F, unsigned char* ws, int first, int last, int w, int nworkers) {
    const int lane = F.lane, wave = F.wave;
    LAS float* scr = (LAS float*)(F.lds + RING_OFF + wave * 16384);
    const int NGW = nworkers * NWAVES;
    TrDesc d0, d1, d2, d3; f32x4 v0[8], v1[8], v2[8], v3[8]; int it = first + w * NWAVES + wave;
#define TR_LD(s, idx) do { const int i_ = (idx); if (i_ < last) { p0_desc(d##s, ws, i_, lane); tr_load(d##s, v##s, lane); } } while (0)
    TR_LD(0, it); TR_LD(1, it + NGW); TR_LD(2, it + 2 * NGW);
    while (it < last) {
        TR_LD(3, it + 3 * NGW); tr_finish(d0, v0, scr, lane); it += NGW; if (it >= last) break;
        TR_LD(0, it + 3 * NGW); tr_finish(d1, v1, scr, lane); it += NGW; if (it >= last) break;
        TR_LD(1, it + 3 * NGW); tr_finish(d2, v2, scr, lane); it += NGW; if (it >= last) break;
        TR_LD(2, it + 3 * NGW); tr_finish(d3, v3, scr, lane); it += NGW;
    }
#undef TR_LD
}
#ifndef BG_PER_WAVE
#define BG_PER_WAVE 6
#endif
constexpr int BG_HALF = 128 * NWAVES * BG_PER_WAVE, BG_ITEMS = 2 * BG_HALF;
__device__ __forceinline__ void p0_prologue(Frame& F, unsigned char* ws) {
    const int gw = F.vcu * NWAVES + F.wave, NGW = F.G * NWAVES;
#if defined(PROBE_DUP) && defined(P0_DUP_PART)
#define P0_PART(k) ((P0_DUP_PART >> (k)) & 1)
#else
#define P0_PART(k) 1
#endif
    if (P0_PART(0)) tr_items(F, ws, BG_ITEMS, P0_NITEMS, F.vcu, F.G);
    const int* pos = (const int*)P0_IN(1);
    const int gt = F.vcu * (NWAVES * 64) + F.tid, NGT = F.G * NWAVES * 64;
    if (P0_PART(1)) for (int idx = gt; idx < NTOK * 48; idx += NGT) {
        const int tok = idx / 48, j = idx % 48; const bool m = j < 16; const int i = m ? j : j - 16;
        const float ang = (float)pos[tok] * INV_FREQ64[m ? 2 * i : i];
        float sn_, cn_; sincosf(ang, &sn_, &cn_); f32x2 cs; cs.x = cn_; cs.y = sn_;
        if (m) *(f32x2*)(ws + WS_CSM + ((size_t)tok * 16 + i) * 8) = cs; else *(f32x2*)(ws + WS_CSS + ((size_t)tok * 32 + i) * 8) = cs;
    }
    const float* g0 = P0_IN(2);
    if (P0_PART(2)) for (int m = gw; m < NTOK; m += NGW) {
        const GAS f32x4* xr = (const GAS f32x4*)(P0_IN(0) + (size_t)m * DM) + F.lane;
        f32x4 v[4]; float s = 0.f;
#pragma unroll
        for (int j = 0; j < 4; ++j) { v[j] = xr[64 * j]; s += (v[j].x * v[j].x + v[j].y * v[j].y) + (v[j].z * v[j].z + v[j].w * v[j].w); }
        const float rstd = 1.f / sqrtf(wave_sum(s) * (1.f / DM) + RMS_EPS);
        GAS unsigned long long* o8 = (GAS unsigned long long*)((bf16*)(ws + WS_XB) + (size_t)m * DM) + F.lane;
#pragma unroll
        for (int j = 0; j < 4; ++j) { const f32x4 g = *((const f32x4*)g0 + F.lane + 64 * j);
            o8[64 * j] = (unsigned long long)pk2(v[j].x * rstd * g.x, v[j].y * rstd * g.y) | ((unsigned long long)pk2(v[j].z * rstd * g.z, v[j].w * rstd * g.w) << 32); }
    }
}

__device__ __forceinline__ float fox_norm1(const v4u (&w)[8]) { float s = 0.f;
#pragma unroll
    for (int c = 0; c < 8; ++c)
#pragma unroll
        for (int e = 0; e < 4; ++e) { const float lo = bf2f(w[c][e] & 0xffffu), hi = bf2f(w[c][e] >> 16); s += lo * lo + hi * hi; }
#pragma unroll
    for (int o = 1; o < 64; o <<= 1) s = fmaxf(s, shx(s, o));
    return sqrtf(s) * 1.0001f; }
__device__ __forceinline__ void fox_norms(Frame& F, const bf16* FQ, const bf16* FK, float* FAUX, int w, int nworkers) {
    const int gw = w * NWAVES + F.wave, NGW = nworkers * NWAVES;
#define FOXN_SRC(it) (((it) >> 12 ? FQ : FK) + ((size_t)(((((it) >> 7) & 31) >> 3) * SEQ + 64 * ((it) & 127) + F.lane)) * 512 + ((((it) >> 7) & 31) & 7) * 64)
#define FOXN_DST(it) FAUX[(size_t)(((it) >> 7) & 31) * 512 + ((it) >> 12 ? 384 : 0) + ((it) & 127)]
    for (int it = gw; it < 8192; it += 2 * NGW) {
        const int it2 = it + NGW; const bool two = it2 < 8192;
        v4u wa[8], wb[8]; const bf16* sa = FOXN_SRC(it); const bf16* sb = FOXN_SRC(two ? it2 : it);
#pragma unroll
        for (int c = 0; c < 8; ++c) { wa[c] = *(const v4u*)(sa + 8 * c); wb[c] = *(const v4u*)(sb + 8 * c); }
        const float na = fox_norm1(wa), nb = fox_norm1(wb);
        if (F.lane == 0) { FOXN_DST(it) = na; if (two) FOXN_DST(it2) = nb; }
    }
#undef FOXN_SRC
#undef FOXN_DST
}
__device__ __forceinline__ void fox_cumsum(Frame& F, const float* FL, const float* bforget, bf16* KB, float* FAUX, int b, int h) {
    const float bh = bforget[h]; const int t0 = 16 * F.tid;
    float ls[16]; double loc = 0.0;
#pragma unroll
    for (int i = 0; i < 16; ++i) { const float z = FL[((size_t)(b * SEQ + t0 + i)) * 8 + h] + bh; const float l = fminf(z, 0.f) - log1pf(expf(-fabsf(z))); loc += (double)l; ls[i] = (float)loc; }
    double inc = loc;
#pragma unroll
    for (int o = 1; o < 64; o <<= 1) {
        const int src = ((F.lane >= o) ? F.lane - o : F.lane) << 2; const long long iv = __builtin_bit_cast(long long, inc);
        const unsigned lo = (unsigned)__builtin_amdgcn_ds_bpermute(src, (int)(unsigned)iv), hi = (unsigned)__builtin_amdgcn_ds_bpermute(src, (int)(unsigned)(iv >> 32));
        const double t = __builtin_bit_cast(double, (long long)(((unsigned long long)hi << 32) | lo)); if (F.lane >= o) inc += t; }
    LAS double* wt = (LAS double*)(F.lds + RING_OFF);
    if (F.lane == 63) wt[F.wave] = inc;
    __syncthreads();
    double base = 0.0;
#pragma unroll
    for (int w = 0; w < 8; ++w) if (w < F.wave) base += wt[w];
    const double excl = base + inc - loc;
    float bmx = -INFINITY, bmn = INFINITY;
#pragma unroll
    for (int i = 0; i < 16; ++i) {
        const float v = -(float)(excl + (double)ls[i]) * LOG2E; bmx = fmaxf(bmx, v); bmn = fminf(bmn, v);
        const unsigned hi = f2bf(v); const float r1 = v - bf2f(hi); const unsigned mid = f2bf(r1); const float r2 = r1 - bf2f(mid); const unsigned lo = f2bf(r2);
        v4u w0; w0.x = hi | (mid << 16); w0.y = lo; w0.z = 0u; w0.w = 0u; const v4u z4 = {0u, 0u, 0u, 0u};
        bf16* dst = KB + ((size_t)(b * SEQ + t0 + i) * 8 + h) * 16;
        *(v4u*)dst = w0; *(v4u*)(dst + 8) = z4;
    }
    bmx = fmaxf(bmx, shx(bmx, 1)); bmx = fmaxf(bmx, shx(bmx, 2)); bmn = fminf(bmn, shx(bmn, 1)); bmn = fminf(bmn, shx(bmn, 2));
    if ((F.tid & 3) == 0) { float* fa = FAUX + (size_t)(b * 8 + h) * 512 + (F.tid >> 2); fa[128] = bmx + 1e-3f; fa[256] = bmn - 1e-3f; }
    __syncthreads();
}

__device__ __forceinline__ void conv_phase(Frame& F, const bf16* GB, const bf16* U, const float* cw, bf16* MIX1) {
    const int gt = F.vcu * (NWAVES * 64) + F.tid, NGT = F.G * NWAVES * 64;
    for (int idx = gt; idx < NTOK * 64; idx += NGT) {
        const int tok = idx >> 6, c8 = (idx & 63) * 8, t = tok & (SEQ - 1);
        const v4u gb = *(const v4u*)(GB + (size_t)tok * 512 + c8), u2 = *(const v4u*)(U + (size_t)tok * 512 + c8);
        v4u u1 = {0u, 0u, 0u, 0u}, u0 = {0u, 0u, 0u, 0u};
        if (t >= 1) u1 = *(const v4u*)(U + (size_t)(tok - 1) * 512 + c8);
        if (t >= 2) u0 = *(const v4u*)(U + (size_t)(tok - 2) * 512 + c8);
        float o[8];
#pragma unroll
        for (int e = 0; e < 8; ++e) { const int sh = (e & 1) * 16; const unsigned m = 0xffffu;
            const float g = bf2f((gb[e >> 1] >> sh) & m), a0 = bf2f((u0[e >> 1] >> sh) & m), a1 = bf2f((u1[e >> 1] >> sh) & m), a2 = bf2f((u2[e >> 1] >> sh) & m);
            o[e] = g * (cw[c8 + e] * a0 + cw[512 + c8 + e] * a1 + cw[1024 + c8 + e] * a2); }
        v4u w; w.x = pk2(o[0], o[1]); w.y = pk2(o[2], o[3]); w.z = pk2(o[4], o[5]); w.w = pk2(o[6], o[7]);
        *(v4u*)(MIX1 + (size_t)tok * 1024 + 512 + c8) = w;
    }
}

__device__ __forceinline__ void router_phase(Frame& F, const bf16* h3, const float* gnorm, const float* wr, ListEnt* LIST, gu32* ctl) {
    float wq[4][4][8];
#pragma unroll
    for (int j = 0; j < 4; ++j)
#pragma unroll
        for (int e = 0; e < 4; ++e) { const int k = 256 * j + 4 * F.lane + e; const float g = gnorm[k];
#pragma unroll
            for (int x = 0; x < 8; ++x) wq[j][e][x] = g * wr[k * 8 + x]; }
    LAS float* info = (LAS float*)(F.lds + RING_OFF);
    LAS unsigned* cl = (LAS unsigned*)(F.lds + RING_OFF + 8192);
    if (F.tid < 32) cl[F.tid] = 0u;
    __syncthreads();
    const int row0 = (int)blockIdx.x * 128;
    for (int j = 0; j < 16; ++j) {
        const int lr = F.wave * 16 + j, row = row0 + lr;
        const GAS unsigned long long* xr = (const GAS unsigned long long*)(h3 + (size_t)row * DM) + F.lane;
        float s = 0.f, lg[8];
#pragma unroll
        for (int x = 0; x < 8; ++x) lg[x] = 0.f;
#pragma unroll
        for (int q = 0; q < 4; ++q) { const unsigned long long w_ = xr[64 * q]; const unsigned lo_ = (unsigned)w_, hi_ = (unsigned)(w_ >> 32);
            f32x4 v; v.x = __uint_as_float(lo_ << 16); v.y = __uint_as_float(lo_ & 0xffff0000u); v.z = __uint_as_float(hi_ << 16); v.w = __uint_as_float(hi_ & 0xffff0000u); s += (v.x * v.x + v.y * v.y) + (v.z * v.z + v.w * v.w);
#pragma unroll
            for (int x = 0; x < 8; ++x) lg[x] += (v.x * wq[q][0][x] + v.y * wq[q][1][x]) + (v.z * wq[q][2][x] + v.w * wq[q][3][x]); }
        const float rstd = 1.f / sqrtf(wave_sum(s) * (1.f / DM) + RMS_EPS);
#pragma unroll
        for (int x = 0; x < 8; ++x) lg[x] = wave_sum(lg[x]) * rstd;
        int i0 = 0; float m0 = lg[0];
#pragma unroll
        for (int x = 1; x < 8; ++x) if (lg[x] > m0) { m0 = lg[x]; i0 = x; }
        int i1 = -1; float m1 = -INFINITY;
#pragma unroll
        for (int x = 0; x < 8; ++x) if (x != i0 && lg[x] > m1) { m1 = lg[x]; i1 = x; }
        const float w1 = 1.0f / (1.0f + expf(m0 - m1)), w0 = 1.0f - w1;
        if (F.lane == 0) { info[lr * 8 + 0] = __int_as_float(i0); info[lr * 8 + 1] = __int_as_float(i1); info[lr * 8 + 2] = w0; info[lr * 8 + 3] = w1; info[lr * 8 + 4] = rstd; }
    }
    __syncthreads();
    int e = 0, sl = 0; const int lr = F.tid >> 1, k = F.tid & 1;
    if (F.tid < 256) { e = __float_as_int(info[lr * 8 + k]); sl = (int)atomicAdd((unsigned*)(cl + k * 8 + e), 1u); }
    __syncthreads();
    if (F.tid < 16) cl[16 + F.tid] = __hip_atomic_fetch_add(ctl + CW_CNT + 64 * F.tid, cl[F.tid], RLX_AGENT);
    __syncthreads();
    if (F.tid < 256) { const int slot = (int)cl[16 + k * 8 + e] + sl; ListEnt en; en.tok = row0 + lr; en.gw = info[lr * 8 + 2 + k]; en.rs = info[lr * 8 + 4]; en.pad = 0;
        LIST[((size_t)(k * 8 + e)) * NTOK + slot] = en; }
    __syncthreads();
}

struct MoeOrder {
    pg8::StaticOrder so; int nN; const LAS int* tab; const ListEnt* list; int ufull, rem, ns, part;
    __device__ __forceinline__ void init(LAS int* tab_, const gu32* ctl, const ListEnt* list_, int nN_, int G, int c, bool splitk, bool t0  ) {
        list = list_; nN = nN_; tab = tab_;
        __syncthreads();
        if (t0) { int acc = 0;
            for (int li = 0; li < 16; ++li) { const int ce = (int)__hip_atomic_load(ctl + CW_CNT + 64 * li, RLX_AGENT); tab_[li] = ce; tab_[16 + li] = acc; acc += (ce + 255) >> 8; }
            tab_[32] = acc; }
        __syncthreads();
        int tot = __builtin_amdgcn_readfirstlane(tab_[32]); if (tot > MOE_CAP) tot = MOE_CAP;
        so.init(tot, nN, G, c);
        part = 0; ufull = splitk ? (so.nwg / G) * G : so.nwg; rem = so.nwg - ufull; ns = (7 * rem <= SLAB_CAP) ? 7 : 2;
    }
    __device__ __forceinline__ void unit_of(int lp, int pn, pg8::Unit& u) const {
        int li = 0;
#pragma unroll
        for (int x = 1; x < 16; ++x) if (lp >= __builtin_amdgcn_readfirstlane(tab[16 + x])) li = x;
        const int j = lp - __builtin_amdgcn_readfirstlane(tab[16 + li]); int nv = __builtin_amdgcn_readfirstlane(tab[li]) - 256 * j; if (nv > 256) nv = 256;
        u.pa = lp; u.pb = (li & 7) * nN + pn; u.pm = lp; u.pn = pn; u.e = li; u.nv = nv; u.s0 = 256 * j;
    }
    __device__ __forceinline__ bool next(int i, pg8::Unit& u) const {
        long L = (long)i * so.G + so.c; int lp, pn;
        if (L < ufull) { if (!so.tile_lin(L, lp, pn)) return false; unit_of(lp, pn, u); u.kt0 = 0; u.ntu = DFF / 128; u.slab = -1; return true; }
        const int q = (int)(L - ufull); if (q >= ns * rem) return false;
        const int r = q / ns, ks = q - r * ns, ntu = (DFF / 128) / ns;
        so.tile_lin((long)ufull + r, lp, pn); unit_of(lp, pn, u); u.kt0 = ntu * ks; u.ntu = ntu; u.slab = q; return true;
    }
    __device__ __forceinline__ void fill(const pg8::Unit& u, LAS unsigned* dst, int wid, int lane) const {
        if (wid < 4) __builtin_amdgcn_global_load_lds((const unsigned*)&list[(size_t)u.e * NTOK + u.s0 + wid * 64 + lane].tok, dst + wid * 64, 4, 0, 0);
    }
};
__device__ __forceinline__ void moe_combine(Frame& F, const MoeOrder& S, const float* slabs, bf16* xb, bf16* y0) {
    const int gw = F.vcu * NWAVES + F.wave, NGW = F.G * NWAVES;
    for (int it = gw; it < S.rem * 256; it += NGW) {
        const int r = it >> 8, row = it & 255; int lp, pn; pg8::Unit u; S.so.tile_lin((long)S.ufull + r, lp, pn); S.unit_of(lp, pn, u);
        if (row >= u.nv) continue;
        const ListEnt en = S.list[(size_t)u.e * NTOK + u.s0 + row];
        const float* sp = slabs + ((size_t)(S.ns * r) * 256 + row) * 256 + 4 * F.lane;
        f32x4 s = *(const f32x4*)sp + *(const f32x4*)(sp + 65536);
        if (S.ns == 7) s = (s + (*(const f32x4*)(sp + 2 * 65536) + *(const f32x4*)(sp + 3 * 65536))) + ((*(const f32x4*)(sp + 4 * 65536) + *(const f32x4*)(sp + 5 * 65536)) + *(const f32x4*)(sp + 6 * 65536));
        s = s * (W8_INV * en.gw);
        const size_t off = (size_t)en.tok * DM + pn * 256 + 4 * F.lane;
        f32x4 o = s;
        if (u.e >= 8) { const unsigned long long w_ = *(const unsigned long long*)(xb + off); const unsigned lo_ = (unsigned)w_, hi_ = (unsigned)(w_ >> 32);
            o = o + (f32x4){__uint_as_float(lo_ << 16), __uint_as_float(lo_ & 0xffff0000u), __uint_as_float(hi_ << 16), __uint_as_float(hi_ & 0xffff0000u)}; }
        *(unsigned long long*)((u.e >= 8 ? xb : y0) + off) = (unsigned long long)pk2(o[0], o[1]) | ((unsigned long long)pk2(o[2], o[3]) << 32);
    }
}
constexpr int NPH = 16;
#ifndef RES_SKEW
#define RES_SKEW 0
#endif
__device__ __forceinline__ bool in_phase(int k, int lo, int hi) { asm volatile("" : "+s"(lo), "+s"(hi)); return lo <= k && k < hi; }
static_assert(sizeof(Args) == 25 * 8 + 8 + 8 + 8, "Args has no padding");
__global__ void __launch_bounds__(NWAVES * 64, 2) skel_fwd(Args args) {
    extern __shared__ __attribute__((aligned(16))) unsigned char lds[];
    Frame F;
    F.lds = (LAS unsigned char*)lds;
    F.MISC = (volatile LAS unsigned*)(F.lds + MISC_OFF);
    const int wave0 = __builtin_amdgcn_readfirstlane((int)threadIdx.x >> 6);
#define FRAME_TID() do { int t_ = wave0 * 64 + lane_id(); asm volatile("" : "+v"(t_)); F.tid = t_; F.lane = t_ & 63; F.wave = __builtin_amdgcn_readfirstlane(t_ >> 6); \
        int g_ = gridDim.x, bx_ = blockIdx.x; asm volatile("" : "+s"(g_), "+s"(bx_)); F.G = g_; F.vcu = (g_ % 8 == 0) ? (bx_ % 8) * (g_ / 8) + bx_ / 8 : bx_; } while (0)
    FRAME_TID();
    typedef __attribute__((address_space(4))) const unsigned char* kptr_t;
#define KARG() ({ kptr_t kp_ = (kptr_t)__builtin_amdgcn_kernarg_segment_ptr(); asm volatile("" : "+s"(kp_)); kp_; })
#define ARG_IN(i) (*(const float* const __attribute__((address_space(4)))*)(KARG() + 8 * (i)))
#define ARG_OUT() (*(float* const __attribute__((address_space(4)))*)(KARG() + 200))
#define ARG_WS() (*(unsigned char* const __attribute__((address_space(4)))*)(KARG() + 208))
#define ARG_LO() (*(const int __attribute__((address_space(4)))*)(KARG() + 216))
#define ARG_HI() (*(const int __attribute__((address_space(4)))*)(KARG() + 220))
#define ws (ARG_WS())
#define FCTL ((gu32*)(ws + WS_CTL))
    for (int u = F.tid; u < (LDS_BYTES - LDSCTL_OFF) / 4; u += NWAVES * 64) ((LAS unsigned*)(F.lds + LDSCTL_OFF))[u] = 0u;
    __syncthreads();
    XcdBarrier bar = xcd_barrier_post((unsigned*)(FCTL + CW_BAR), F.MISC + 8, F.tid == 0);
    const int lo = ARG_LO(), hi = ARG_HI();
#ifndef PH_MASK
#define PH_MASK 0xFFFF
#endif
#define IN(k) (((PH_MASK >> (k)) & 1) && in_phase((k), lo, hi))
#define SEAM(k) do { if (IN(k) && IN((k) + 1)) { FRAME_TID(); xcd_barrier(bar, F.tid == 0); } } while (0)
#define dob ((unsigned char*)ARG_OUT())
#define ssq_q ((float*)(ws + WS_PQ))
#define ssq_kv ((float*)(ws + WS_PKV))
#define ssq_h1 ((float*)(ws + WS_PH))
#define ssq_h2 ((float*)(ws + WS_PH))
#define XB ((bf16*)(ws + WS_XB))
#define bid ((int)blockIdx.x)

#ifdef DIAG_PH
#define TSTAMP(slot) do { if (blockIdx.x == 0 && wave0 == 0 && lane_id() == 0) ((unsigned long long*)(ws + WS_CTL + 49152))[8 + (slot)] = __builtin_amdgcn_s_memrealtime(); } while (0)
#else
#define TSTAMP(slot) do { } while (0)
#endif
    TSTAMP(0);
    if (IN(0)) { FRAME_TID(); p0_prologue(F, ws); }
    SEAM(0); TSTAMP(1);
    if (IN(1)) { FRAME_TID();
        pg8::StaticOrder S; S.init(NTOK / 256, 9, F.G, bid);
        ep::EpiIn0 E{(bf16*)(dob + DO_FQ), (bf16*)(dob + DO_CKV), (bf16*)(ws + WS_CQ), (bf16*)(ws + WS_KPE), (float*)(ws + WS_FL), ssq_q, ssq_kv, (const float*)(ws + WS_CSM)};
        pg8::gemm_phase<ep::EpiIn0, pg8::StaticOrder, false>(F.lds + RING_OFF, F.wave, XB, (const bf16*)(ws + WS_W_IN0), 1024, S, E);
        if (BG_ITEMS > 0 && F.G == 256 && bid >= 128) tr_items(F, ws, 0, BG_HALF, bid - 128, 128);
        else if (BG_ITEMS > 0 && F.G != 256) tr_items(F, ws, 0, BG_HALF, bid, F.G);
    }
    SEAM(1); TSTAMP(2);
    if (IN(2)) { FRAME_TID();
#if defined(PROBE_DUP) && defined(P2_DUP_PARTS)
#define P2_PARTS P2_DUP_PARTS
#else
#define P2_PARTS 15
#endif
        if (P2_PARTS & 8) { if (F.G == 256) { if (bid >= 160) fox_norms(F, (const bf16*)(dob + DO_FQ), (const bf16*)(dob + DO_FK), (float*)(ws + WS_FAUX), bid - 160, 96); }
                            else fox_norms(F, (const bf16*)(dob + DO_FQ), (const bf16*)(dob + DO_FK), (float*)(ws + WS_FAUX), bid, F.G); }
        if ((P2_PARTS & 1) && bid >= 128 && bid < 160) fox_cumsum(F, (const float*)(ws + WS_FL), ARG_IN(4), (bf16*)(dob + DO_KB), (float*)(ws + WS_FAUX), (bid - 128) >> 3, (bid - 128) & 7);
        if (P2_PARTS & 2) { pg8::StaticOrder S; S.init(NTOK / 256, 3, F.G, bid);
          ep::EpiQup E{(bf16*)(ws + WS_MQ), ssq_q, (const float*)(ws + WS_CSM)};
          pg8::gemm_phase<ep::EpiQup, pg8::StaticOrder, false>(F.lds + RING_OFF, F.wave, (const bf16*)(ws + WS_CQ), (const bf16*)(ws + WS_W_QUP), 384, S, E); }
        if (P2_PARTS & 4) { pg8::StaticOrder S; S.init(NTOK / 256, 4, F.G, bid);
          ep::EpiKVup E{(bf16*)(ws + WS_MKV), ssq_kv};
          pg8::gemm_phase<ep::EpiKVup, pg8::StaticOrder, false>(F.lds + RING_OFF, F.wave, (const bf16*)(dob + DO_CKV), (const bf16*)(ws + WS_W_KVUP), 256, S, E); }
    }
#undef P2_PARTS
    SEAM(2); TSTAMP(3);
    if (IN(3)) { FRAME_TID();
        const int bh = F.vcu >> 3, s = F.vcu & 7, b = bh >> 3, h = bh & 7; const size_t rb = (size_t)b * SEQ;
        bf16* MIX0 = (bf16*)(ws + WS_MIX0);
#if !defined(PROBE_DUP) || !defined(P3_DUP_PART) || (P3_DUP_PART & 1)
        { att::Ptrs A; const bf16* FQ = (const bf16*)(dob + DO_FQ); const bf16* FK = (const bf16*)(dob + DO_FK); const bf16* FV = (const bf16*)(dob + DO_FV); const bf16* KB = (const bf16*)(dob + DO_KB);
          A.Qm = FQ + rb * 512 + h * 64; A.qp = 512; A.Qx = nullptr; A.qxp = 0; A.Km = FK + rb * 512 + h * 64; A.kp = 512; A.Kx = KB + rb * 128 + h * 16; A.kxp = 128;
          A.V = FV + rb * 512 + h * 64; A.vp = 512; A.O = MIX0 + rb * 1024 + h * 64; A.op = 1024; A.aux = (const float*)(ws + WS_FAUX) + (size_t)bh * 512;
#pragma nounroll
          for (int i = 0; i < 4; ++i) { const int qb = (i == 0) ? s : (i == 1) ? 15 - s : (i == 2) ? 16 + s : 31 - s; att::attn_unit<5, 0, true>(A, qb * 256, 0.f, (char*)lds + RING_OFF, F.wave); } }
#endif
#if !defined(PROBE_DUP) || !defined(P3_DUP_PART) || (P3_DUP_PART & 2)
        { att::Ptrs A; const bf16* MQ = (const bf16*)(ws + WS_MQ); const bf16* MKV = (const bf16*)(ws + WS_MKV); const bf16* KPE = (const bf16*)(ws + WS_KPE);
          A.Qm = MQ + rb * 768 + h * 96; A.qp = 768; A.Qx = A.Qm + 64; A.qxp = 768; A.Km = MKV + rb * 1024 + h * 128; A.kp = 1024; A.Kx = KPE + rb * 32; A.kxp = 32;
          A.V = MKV + rb * 1024 + h * 128 + 64; A.vp = 1024; A.O = MIX0 + rb * 1024 + 512 + h * 64; A.op = 1024;
#pragma nounroll
          for (int i = 0; i < 4; ++i) { const int qb = (i == 0) ? s : (i == 1) ? 15 - s : (i == 2) ? 16 + s : 31 - s; att::attn_unit<6, 0, false>(A, qb * 256, 0.f, (char*)lds + RING_OFF, F.wave); } }
#endif
    }
    SEAM(3); TSTAMP(4);
    if (IN(4)) { FRAME_TID();
        pg8::StaticOrder S; S.init(NTOK / 256, 4, F.G, bid);
        ep::EpiRes<false, false> E{ARG_IN(0), nullptr, nullptr, XB, ssq_h1, nullptr};
        pg8::gemm_phase<ep::EpiRes<false, false>, pg8::StaticOrder, false>(F.lds + RING_OFF, F.wave, (const bf16*)(ws + WS_MIX0), (const bf16*)(ws + WS_W_OUT0), 1024, S, E, nullptr, RES_SKEW);
    }
    SEAM(4); TSTAMP(5);
    if (IN(5)) { FRAME_TID();
        pg8::StaticOrder S; S.init(NTOK / 256, 28, F.G, bid);
#if defined(PROBE_DUP) && defined(P5_DUP_MODE)
        ep::EpiGU E{(bf16*)(ws + WS_HID0), ssq_h1, P5_DUP_MODE};
#else
        ep::EpiGU E{(bf16*)(ws + WS_HID0), ssq_h1, 0};
#endif
        { int last = -1;
#pragma nounroll
          for (int i = 0; ; ++i) { int pm, pn; if (!S.tile(i, pm, pn)) break; if (pm != last) { rstd_rows(F, ssq_h1, ssq_q, pm); last = pm; } }
          VM_WAIT(); __syncthreads(); }
        E.part = ssq_q;
#ifdef PG8_DIAG
        pg8::gemm_phase<ep::EpiGU, pg8::StaticOrder, false>(F.lds + RING_OFF, F.wave, XB, (const bf16*)(ws + WS_W_GU0), 1024, S, E, (bid == 0) ? (unsigned long long*)(ws + WS_CTL + 49152) : nullptr);
#else
        pg8::gemm_phase<ep::EpiGU, pg8::StaticOrder, false>(F.lds + RING_OFF, F.wave, XB, (const bf16*)(ws + WS_W_GU0), 1024, S, E);
#endif
    }
    SEAM(5); TSTAMP(6);
    if (IN(6)) { FRAME_TID();
        pg8::StaticOrder S; S.init(NTOK / 256, 4, F.G, bid);
        ep::EpiRes<true, false> E{nullptr, XB, nullptr, XB, ssq_h2, IN1_FP8 ? ws + WS_XB8 : nullptr};
        pg8::gemm_phase<ep::EpiRes<true, false>, pg8::StaticOrder, false, false, true>(F.lds + RING_OFF, F.wave, (const bf16*)(ws + WS_HID0), (const bf16*)(ws + WS_W_D0), DFF, S, E);
    }
    SEAM(6); TSTAMP(7);
    if (IN(7)) { FRAME_TID();
        pg8::StaticOrder S; S.init(NTOK / 256, 9, F.G, bid);
        ep::EpiIn1 E{(bf16*)(ws + WS_SQ), (bf16*)(ws + WS_SK), (bf16*)(ws + WS_SV), (bf16*)(ws + WS_GB), (bf16*)(ws + WS_U), ssq_h2, (const float*)(ws + WS_CSS)};
#if IN1_FP8
        pg8::gemm_phase<ep::EpiIn1, pg8::StaticOrder, false, false, false, 2>(F.lds + RING_OFF, F.wave, (const bf16*)(ws + WS_XB8), (const bf16*)(ws + WS_W_IN1), 512, S, E);
#else
        pg8::gemm_phase<ep::EpiIn1, pg8::StaticOrder, false>(F.lds + RING_OFF, F.wave, XB, (const bf16*)(ws + WS_W_IN1), 1024, S, E);
#endif
        if (BG_ITEMS > 0 && F.G == 256 && bid >= 128) tr_items(F, ws, BG_HALF, BG_ITEMS, bid - 128, 128);
        else if (BG_ITEMS > 0 && F.G != 256) tr_items(F, ws, BG_HALF, BG_ITEMS, bid, F.G);
    }
    SEAM(7); TSTAMP(8);
    if (IN(8)) { FRAME_TID();
        bf16* MIX1 = (bf16*)(ws + WS_MIX1);
        if (bid & 1) { conv_phase(F, (const bf16*)(ws + WS_GB), (const bf16*)(ws + WS_U), ARG_IN(17), MIX1); __syncthreads(); }
#pragma nounroll
        for (int i = 0; i < 4; ++i) {
            const int L = F.vcu * 4 + i, qb = L & 31, hq = (L >> 5) & 7, b = L >> 8; const size_t rb = (size_t)b * SEQ;
            att::Ptrs A; A.Qm = (const bf16*)(ws + WS_SQ) + rb * 512 + hq * 64; A.qp = 512; A.Qx = nullptr; A.qxp = 0; A.Km = (const bf16*)(ws + WS_SK) + rb * 128 + (hq >> 2) * 64; A.kp = 128; A.Kx = nullptr; A.kxp = 0;
            A.V = (const bf16*)(ws + WS_SV) + rb * 128 + (hq >> 2) * 64; A.vp = 128; A.O = MIX1 + rb * 1024 + hq * 64; A.op = 1024;
            att::attn_unit<4, 1, false>(A, qb * 256, ARG_IN(16)[hq] * LOG2E, (char*)lds + RING_OFF, F.wave);
        }
        if (!(bid & 1)) { FRAME_TID(); conv_phase(F, (const bf16*)(ws + WS_GB), (const bf16*)(ws + WS_U), ARG_IN(17), MIX1); }
    }
    SEAM(8); TSTAMP(9);
    if (IN(9)) { FRAME_TID();
        pg8::StaticOrder S; S.init(NTOK / 256, 4, F.G, bid);
        ep::EpiRes<true, false> E{nullptr, XB, nullptr, XB, nullptr, ws + WS_XB8};
        pg8::gemm_phase<ep::EpiRes<true, false>, pg8::StaticOrder, false>(F.lds + RING_OFF, F.wave, (const bf16*)(ws + WS_MIX1), (const bf16*)(ws + WS_W_OUT1), 1024, S, E, nullptr, RES_SKEW);
    }
    SEAM(9); TSTAMP(10);
#define LIST ((ListEnt*)(ws + WS_LIST))
    if (IN(10)) { FRAME_TID(); router_phase(F, XB, ARG_IN(19), ARG_IN(20), LIST, FCTL); }
    SEAM(10); TSTAMP(11);
#define Y0 ((bf16*)(ws + WS_Y0))
    if (IN(11)) { FRAME_TID();
        MoeOrder S; S.init((LAS int*)(F.lds + LDSCTL_OFF), FCTL, LIST, 28, F.G, bid, false, F.tid == 0);
        ep::EpiMoe1 E{(bf16*)(ws + WS_HID1), LIST};
        pg8::gemm_phase<ep::EpiMoe1, MoeOrder, true, false, false, 2>(F.lds + RING_OFF, F.wave, (const bf16*)(ws + WS_XB8), (const bf16*)(ws + WS_WMOE_GU), 512, S, E);
    }
    SEAM(11); TSTAMP(12);
    if (IN(12)) { FRAME_TID();
        MoeOrder S; S.init((LAS int*)(F.lds + LDSCTL_OFF), FCTL, LIST, 4, F.G, bid, true, F.tid == 0);
        ep::EpiMoe2 E{XB, Y0, LIST, ARG_OUT()};
        pg8::gemm_phase<ep::EpiMoe2, MoeOrder, false, true, true, 2>(F.lds + RING_OFF, F.wave, (const bf16*)(ws + WS_HID1), (const bf16*)(ws + WS_WMOE_D), DFF / 2, S, E);
    }
    SEAM(12); TSTAMP(13);
    if (IN(13)) { FRAME_TID();
        MoeOrder S1; S1.init((LAS int*)(F.lds + LDSCTL_OFF), FCTL, LIST, 4, F.G, bid, true, F.tid == 0); moe_combine(F, S1, ARG_OUT(), XB, Y0);
    }
    SEAM(13); TSTAMP(14);
    if (IN(14)) { FRAME_TID();
        const int gw = F.vcu * NWAVES + F.wave, NGW = F.G * NWAVES; const float* gf = ARG_IN(24);
        for (int m = gw; m < NTOK; m += NGW) {
            const GAS unsigned long long* xs = (const GAS unsigned long long*)(XB + (size_t)m * DM) + F.lane;
            const GAS unsigned long long* ys = (const GAS unsigned long long*)(Y0 + (size_t)m * DM) + F.lane;
            GAS f32x4* xr = (GAS f32x4*)(ARG_OUT() + (size_t)m * DM) + F.lane;
            f32x4 v[4]; float s = 0.f;
#pragma unroll
            for (int j = 0; j < 4; ++j) { const unsigned long long w_ = xs[64 * j]; const unsigned lo_ = (unsigned)w_, hi_ = (unsigned)(w_ >> 32);
                const unsigned long long y_ = ys[64 * j]; const unsigned ylo_ = (unsigned)y_, yhi_ = (unsigned)(y_ >> 32);
                v[j] = (f32x4){__uint_as_float(lo_ << 16), __uint_as_float(lo_ & 0xffff0000u), __uint_as_float(hi_ << 16), __uint_as_float(hi_ & 0xffff0000u)}
                     + (f32x4){__uint_as_float(ylo_ << 16), __uint_as_float(ylo_ & 0xffff0000u), __uint_as_float(yhi_ << 16), __uint_as_float(yhi_ & 0xffff0000u)};
                s += (v[j].x * v[j].x + v[j].y * v[j].y) + (v[j].z * v[j].z + v[j].w * v[j].w); }
            const float rstd = 1.f / sqrtf(wave_sum(s) * (1.f / DM) + RMS_EPS);
#pragma unroll
            for (int j = 0; j < 4; ++j) { const f32x4 g = *((const f32x4*)gf + F.lane + 64 * j); xr[64 * j] = v[j] * rstd * g; }
#ifdef DIAG_PH
            { const unsigned long long* dg = (const unsigned long long*)(ws + WS_CTL + 49152); float val = (float)(dg[8 + DIAG_PH + 1] - dg[8 + DIAG_PH]) * 0.01f / DIAG_DIV;
              val = exp2f((rintf(log2f(val) * DIAG_RES + DIAG_PHASE) - DIAG_PHASE) / DIAG_RES);
#pragma unroll
              for (int j = 0; j < 4; ++j) xr[64 * j] = (f32x4){val, val, val, val}; }
#endif
#ifdef PG8_DIAG
            { const unsigned long long* dg = (const unsigned long long*)(ws + WS_CTL + 49152); float val;
              if (PG8_DIAG == 1) val = (float)(dg[0] + dg[1]) / ((float)dg[2] * 10.0f) * 10.0f;
              else if (PG8_DIAG == 2) val = (float)dg[0] / (float)dg[3] / 2000.0f;
              else val = (float)dg[1] / (float)dg[3] / 500.0f;
              val = exp2f((rintf(log2f(val) * DIAG_RES + DIAG_PHASE) - DIAG_PHASE) / DIAG_RES);
#pragma unroll
              for (int j = 0; j < 4; ++j) xr[64 * j] = (f32x4){val, val, val, val}; }
#endif
        }
    }
#undef IN
#undef SEAM
#undef ws
#undef dob
#undef ssq_q
#undef ssq_kv
#undef ssq_h1
#undef ssq_h2
#undef XB
#undef bid
#undef LIST
#undef Y0
#undef FCTL
}

#ifndef DBG_STOP
#define DBG_STOP NPH
#endif
#ifndef DBG_STAGE
#define DBG_STAGE -1
#endif
extern "C" void kernel_launch(void* const* d_in, const int* in_sizes, int n_in, void* d_out, int out_size, void* d_ws, size_t ws_size, hipStream_t stream) {
    static int grid = 0;
    if (grid == 0) {
        if (n_in != 25 || in_sizes[0] != NTOK * DM || out_size != NTOK * DM || ws_size < WS_END) { fprintf(stderr, "kernel_launch: unexpected shapes / workspace (n_in %d, ws %zu)\n", n_in, ws_size); grid = -1; return; }
        int dev = 0, cus = 0, per_cu = 0;
        if (hipGetDevice(&dev) != hipSuccess || hipDeviceGetAttribute(&cus, hipDeviceAttributeMultiprocessorCount, dev) != hipSuccess) { grid = -1; return; }
        if (hipFuncSetAttribute((const void*)skel_fwd, hipFuncAttributeMaxDynamicSharedMemorySize, LDS_BYTES) != hipSuccess) { fprintf(stderr, "kernel_launch: hipFuncSetAttribute failed\n"); grid = -1; return; }
        if (hipOccupancyMaxActiveBlocksPerMultiprocessor(&per_cu, (const void*)skel_fwd, NWAVES * 64, LDS_BYTES) != hipSuccess || per_cu < 1) fprintf(stderr, "kernel_launch: occupancy query reports %d\n", per_cu);
        (void)hipGetLastError();
        grid = cus;
        if (grid != 256) { fprintf(stderr, "kernel_launch: built for 256 CUs, found %d\n", grid); grid = -1; return; }
    }
    if (grid < 0) return;
    if (hipMemsetAsync((char*)d_ws + WS_CTL, 0, CTL_ZERO_BYTES, stream) != hipSuccess) return;
    Args a{};
    for (int i = 0; i < 25; ++i) a.in[i] = (const float*)d_in[i];
    a.out = (float*)d_out; a.ws = (unsigned char*)d_ws; a.ph_lo = 0; a.ph_hi = DBG_STOP;
    hipLaunchKernelGGL(skel_fwd, dim3(grid), dim3(NWAVES * 64), LDS_BYTES, stream, a);
#if DBG_STAGE >= 1
    {   nv::Bufs B = nv::carve((unsigned char*)d_ws);
        for (int b = 0; b < 4; ++b) {
            float* hout = (float*)d_out + (size_t)b * nv::T * nv::DM;
#if DBG_STAGE == 1
            hipLaunchKernelGGL(nv::k_bf16_to_f32, dim3(nv::T * 1024 / 256), dim3(256), 0, stream, (const unsigned short*)((unsigned char*)d_ws + WS_MIX0) + (size_t)b * nv::T * 1024, B.mix, (size_t)nv::T * 1024);
#elif DBG_STAGE == 3
            hipLaunchKernelGGL(nv::k_bf16_to_f32, dim3(nv::T * 1024 / 256), dim3(256), 0, stream, (const unsigned short*)((unsigned char*)d_ws + WS_MIX1) + (size_t)b * nv::T * 1024, B.mix, (size_t)nv::T * 1024);
#endif
            nv::forward_batch(stream, d_in, b, hout, B, DBG_STAGE);
        } }
#endif
}
```
